# Optimizing an MI355X kernel written in HIP

```python
import math
import jax, jax.numpy as jnp
from jax import lax
import numpy as np

D_MODEL = 2048
BATCH = 1
SEQ = 16384
DEPTH = 1

SSM_GROUP = 16
SSM_WIDTH = D_MODEL // 2
SSM_GROUPS = SSM_WIDTH // SSM_GROUP
SSM_STATE = 64
DT_MIN = 0.001
DT_MAX = 0.1
N_HEADS = 16
QK_NOPE = 128
QK_ROPE = 64
V_HEAD = 128
Q_LORA = 512
KV_LORA = 512
ROPE_THETA = 10000.0
BLOCK_Q = 128
N_BRANCHES = 2
GATE_WIDTH = N_BRANCHES * D_MODEL
IN_WIDTH = SSM_WIDTH + Q_LORA + KV_LORA + QK_ROPE + GATE_WIDTH
D_FF = -(-8 * D_MODEL // (3 * 256)) * 256
DEEPNORM_ALPHA = (2.0 * DEPTH) ** 0.25
DEEPNORM_BETA = (8.0 * DEPTH) ** -0.25
LN_EPS = 1e-5
RMS_EPS = 1e-6

kernel_name = "hybrid_s5_mla_gated_deepnorm"


def layer_norm(x, g, b):
    x32 = x.astype(jnp.float32)
    mu = jnp.mean(x32, axis=-1, keepdims=True)
    var = jnp.mean(jnp.square(x32 - mu), axis=-1, keepdims=True)
    y = (x32 - mu) * lax.rsqrt(var + LN_EPS) * g.astype(jnp.float32) + b.astype(jnp.float32)
    return y.astype(x.dtype)


def rms_norm(x, g):
    x32 = x.astype(jnp.float32)
    y = x32 * lax.rsqrt(jnp.mean(jnp.square(x32), axis=-1, keepdims=True) + RMS_EPS)
    return (y * g.astype(jnp.float32)).astype(x.dtype)


def rope_tables(positions):
    inv_freq = 1.0 / (ROPE_THETA ** (jnp.arange(0, QK_ROPE, 2, dtype=jnp.float32) / QK_ROPE))
    ang = positions.astype(jnp.float32)[..., None] * inv_freq
    return jnp.cos(ang), jnp.sin(ang)


def apply_rope(t, cos, sin):
    t32 = t.astype(jnp.float32)
    t1, t2 = jnp.split(t32, 2, axis=-1)
    out = jnp.concatenate([t1 * cos - t2 * sin, t1 * sin + t2 * cos], axis=-1)
    return out.astype(t.dtype)


def s5_scan(u, lam_re, lam_im, log_dt, b_re, b_im, c_re, c_im, d_skip):
    f32 = jnp.float32
    bsz, seq, _ = u.shape
    u32 = u.astype(f32).reshape(bsz, seq, SSM_GROUPS, SSM_GROUP)
    lam_re = lam_re.astype(f32)
    lam_im = lam_im.astype(f32)
    dt = jnp.exp(log_dt.astype(f32))[:, None]
    mag = jnp.exp(lam_re * dt)
    ang = lam_im * dt
    abar_re = mag * jnp.cos(ang)
    abar_im = mag * jnp.sin(ang)
    den = jnp.square(lam_re) + jnp.square(lam_im)
    num_re = abar_re - 1.0
    coef_re = (num_re * lam_re + abar_im * lam_im) / den
    coef_im = (abar_im * lam_re - num_re * lam_im) / den
    b_re = b_re.astype(f32)
    b_im = b_im.astype(f32)
    bbar_re = coef_re[..., None] * b_re - coef_im[..., None] * b_im
    bbar_im = coef_re[..., None] * b_im + coef_im[..., None] * b_re
    bu_re = jnp.einsum('bsgp,gnp->bsgn', u32, bbar_re)
    bu_im = jnp.einsum('bsgp,gnp->bsgn', u32, bbar_im)
    a_re = jnp.broadcast_to(abar_re, bu_re.shape)
    a_im = jnp.broadcast_to(abar_im, bu_im.shape)

    def combine(left, right):
        ar1, ai1, br1, bi1 = left
        ar2, ai2, br2, bi2 = right
        ar = ar1 * ar2 - ai1 * ai2
        ai = ar1 * ai2 + ai1 * ar2
        br = ar2 * br1 - ai2 * bi1 + br2
        bi = ar2 * bi1 + ai2 * br1 + bi2
        return ar, ai, br, bi

    _, _, st_re, st_im = lax.associative_scan(combine, (a_re, a_im, bu_re, bu_im), axis=1)
    y = (jnp.einsum('bsgn,gpn->bsgp', st_re, c_re.astype(f32))
         - jnp.einsum('bsgn,gpn->bsgp', st_im, c_im.astype(f32))
         + d_skip.astype(f32) * u32)
    return y.reshape(bsz, seq, SSM_WIDTH).astype(u.dtype)


def mla_attention(q_nope, q_rope, k_nope, k_rope, v):
    bsz, seq = q_nope.shape[:2]
    n_blocks = seq // BLOCK_Q
    scale = 1.0 / math.sqrt(QK_NOPE + QK_ROPE)
    qn_b = q_nope.reshape(bsz, n_blocks, BLOCK_Q, N_HEADS, QK_NOPE).transpose(1, 0, 2, 3, 4)
    qr_b = q_rope.reshape(bsz, n_blocks, BLOCK_Q, N_HEADS, QK_ROPE).transpose(1, 0, 2, 3, 4)
    key_pos = jnp.arange(seq)

    def attend(args):
        blk, qn, qr = args
        s = (jnp.einsum('bqhd,bkhd->bhqk', qn, k_nope)
             + jnp.einsum('bqhr,bkr->bhqk', qr, k_rope)).astype(jnp.float32) * scale
        q_pos = blk * BLOCK_Q + jnp.arange(BLOCK_Q)
        mask = key_pos[None, :] <= q_pos[:, None]
        s = jnp.where(mask[None, None], s, -jnp.inf)
        p = jax.nn.softmax(s, axis=-1).astype(v.dtype)
        return jnp.einsum('bhqk,bkhd->bqhd', p, v)

    o = lax.map(attend, (jnp.arange(n_blocks), qn_b, qr_b))
    return o.transpose(1, 0, 2, 3, 4).reshape(bsz, seq, N_HEADS * V_HEAD)


def setup_inputs(seed: int = 0) -> dict:
    key = jax.random.key(seed)
    ks = jax.random.split(key, 26)
    f32 = jnp.float32
    L = DEPTH

    def nrm(k, shape, scale):
        return jax.random.normal(k, shape, f32) * scale

    x = jax.random.normal(ks[0], (BATCH, SEQ, D_MODEL), f32)
    offset = jax.random.randint(ks[1], (BATCH, 1), 0, 4096, dtype=jnp.int32)
    positions = offset + jnp.arange(SEQ, dtype=jnp.int32)[None, :]

    w_in = nrm(ks[2], (L, D_MODEL, IN_WIDTH), D_MODEL ** -0.5)
    ssm_lambda_re = -0.5 + nrm(ks[3], (L, SSM_GROUPS, SSM_STATE), 0.01)
    ssm_lambda_im = (math.pi * jnp.arange(SSM_STATE, dtype=f32))[None, None, :] + nrm(ks[4], (L, SSM_GROUPS, SSM_STATE), 0.01)
    ssm_log_dt = jax.random.uniform(ks[5], (L, SSM_GROUPS), f32, math.log(DT_MIN), math.log(DT_MAX))
    ssm_b_re = nrm(ks[6], (L, SSM_GROUPS, SSM_STATE, SSM_GROUP), (2.0 * SSM_GROUP) ** -0.5)
    ssm_b_im = nrm(ks[7], (L, SSM_GROUPS, SSM_STATE, SSM_GROUP), (2.0 * SSM_GROUP) ** -0.5)
    ssm_c_re = nrm(ks[8], (L, SSM_GROUPS, SSM_GROUP, SSM_STATE), (2.0 * SSM_STATE) ** -0.5)
    ssm_c_im = nrm(ks[9], (L, SSM_GROUPS, SSM_GROUP, SSM_STATE), (2.0 * SSM_STATE) ** -0.5)
    ssm_d = nrm(ks[10], (L, SSM_GROUPS, SSM_GROUP), 1.0)
    w_glu = nrm(ks[11], (L, SSM_WIDTH, 2 * D_MODEL), SSM_WIDTH ** -0.5)

    q_norm_g = 1.0 + nrm(ks[12], (L, Q_LORA), 0.02)
    w_uq = nrm(ks[13], (L, Q_LORA, N_HEADS * (QK_NOPE + QK_ROPE)), Q_LORA ** -0.5)
    kv_norm_g = 1.0 + nrm(ks[14], (L, KV_LORA), 0.02)
    w_ukv = nrm(ks[15], (L, KV_LORA, N_HEADS * (QK_NOPE + V_HEAD)), KV_LORA ** -0.5)

    w_out = nrm(ks[16], (L, D_MODEL, D_MODEL), DEEPNORM_BETA * D_MODEL ** -0.5)
    ln1_g = 1.0 + nrm(ks[17], (L, D_MODEL), 0.02)
    ln1_b = nrm(ks[18], (L, D_MODEL), 0.02)

    w_ffn_gate = nrm(ks[19], (L, D_MODEL, D_FF), D_MODEL ** -0.5)
    w_ffn_up = nrm(ks[20], (L, D_MODEL, D_FF), D_MODEL ** -0.5)
    w_ffn_down = nrm(ks[21], (L, D_FF, D_MODEL), DEEPNORM_BETA * D_FF ** -0.5)
    ln2_g = 1.0 + nrm(ks[22], (L, D_MODEL), 0.02)
    ln2_b = nrm(ks[23], (L, D_MODEL), 0.02)

    return {
        "x": x, "positions": positions, "w_in": w_in,
        "ssm_lambda_re": ssm_lambda_re, "ssm_lambda_im": ssm_lambda_im, "ssm_log_dt": ssm_log_dt,
        "ssm_b_re": ssm_b_re, "ssm_b_im": ssm_b_im, "ssm_c_re": ssm_c_re, "ssm_c_im": ssm_c_im,
        "ssm_d": ssm_d, "w_glu": w_glu,
        "q_norm_g": q_norm_g, "w_uq": w_uq, "kv_norm_g": kv_norm_g, "w_ukv": w_ukv,
        "w_out": w_out, "ln1_g": ln1_g, "ln1_b": ln1_b,
        "w_ffn_gate": w_ffn_gate, "w_ffn_up": w_ffn_up, "w_ffn_down": w_ffn_down,
        "ln2_g": ln2_g, "ln2_b": ln2_b,
    }


def reference(x, positions, w_in, ssm_lambda_re, ssm_lambda_im, ssm_log_dt, ssm_b_re, ssm_b_im,
              ssm_c_re, ssm_c_im, ssm_d, w_glu, q_norm_g, w_uq, kv_norm_g, w_ukv, w_out,
              ln1_g, ln1_b, w_ffn_gate, w_ffn_up, w_ffn_down, ln2_g, ln2_b):
    bsz, seq, _ = x.shape
    cos, sin = rope_tables(positions)
    cos_h, sin_h = cos[:, :, None, :], sin[:, :, None, :]
    split_at = [SSM_WIDTH, SSM_WIDTH + Q_LORA, SSM_WIDTH + Q_LORA + KV_LORA,
                SSM_WIDTH + Q_LORA + KV_LORA + QK_ROPE]
    h = x
    for l in range(DEPTH):
        z = h @ w_in[l]
        u_ssm, c_q, c_kv, k_rope_raw, gate_logits = jnp.split(z, split_at, axis=-1)

        y_ssm = s5_scan(u_ssm, ssm_lambda_re[l], ssm_lambda_im[l], ssm_log_dt[l], ssm_b_re[l],
                        ssm_b_im[l], ssm_c_re[l], ssm_c_im[l], ssm_d[l])
        glu_a, glu_b = jnp.split(jax.nn.gelu(y_ssm) @ w_glu[l], 2, axis=-1)
        ssm_out = glu_a * jax.nn.sigmoid(glu_b)

        q = (rms_norm(c_q, q_norm_g[l]) @ w_uq[l]).reshape(bsz, seq, N_HEADS, QK_NOPE + QK_ROPE)
        q_nope, q_rope = jnp.split(q, [QK_NOPE], axis=-1)
        q_rope = apply_rope(q_rope, cos_h, sin_h)
        kv = (rms_norm(c_kv, kv_norm_g[l]) @ w_ukv[l]).reshape(bsz, seq, N_HEADS, QK_NOPE + V_HEAD)
        k_nope, v = jnp.split(kv, [QK_NOPE], axis=-1)
        k_rope = apply_rope(k_rope_raw, cos, sin)
        mla_out = mla_attention(q_nope, q_rope, k_nope, k_rope, v)

        g_ssm, g_mla = jnp.split(jax.nn.sigmoid(gate_logits), 2, axis=-1)
        mix = (g_ssm * ssm_out + g_mla * mla_out) @ w_out[l]
        h = layer_norm(DEEPNORM_ALPHA * h + mix, ln1_g[l], ln1_b[l])

        ffn = (jax.nn.silu(h @ w_ffn_gate[l]) * (h @ w_ffn_up[l])) @ w_ffn_down[l]
        h = layer_norm(DEEPNORM_ALPHA * h + ffn, ln2_g[l], ln2_b[l])
    return h
```

```cpp
#include <hip/hip_runtime.h>
#include <hip/hip_cooperative_groups.h>
#include <cstdio>
#include <cstdint>
#include <cmath>
namespace cg = cooperative_groups;

#ifndef PROBE
#define PROBE 0
#endif
#ifndef PROBE_MODE
#define PROBE_MODE 13
#endif
#ifndef USE_MFMA_ATTN
#define USE_MFMA_ATTN 1
#endif
#ifndef USE_MFMA_GEMM
#define USE_MFMA_GEMM 1
#endif

#define LAS __attribute__((address_space(3)))
typedef unsigned short bf16_t;
typedef short bf16x8 __attribute__((ext_vector_type(8)));
typedef float f32x4 __attribute__((ext_vector_type(4)));
typedef float f32x2 __attribute__((ext_vector_type(2)));
typedef unsigned u32x4 __attribute__((ext_vector_type(4)));
typedef unsigned u32x2 __attribute__((ext_vector_type(2)));

constexpr int S_ = 16384, D_ = 2048, NIN = 6400, DFF = 5632;
constexpr float ALPHA = 1.189207115002721f;
constexpr float QSCALE = 0.07216878364870322f * 1.4426950408889634f;
constexpr size_t MiB = 1u << 20;
constexpr size_t WS_SSQ = 0, WS_SSKV = 64 * 1024, WS_AT = 128 * 1024, WS_BAR = 256 * 1024, BAR_BYTES = 16384;
constexpr size_t WS_COS = 4 * MiB, WS_SIN = 6 * MiB;
constexpr size_t W_IN = 8 * MiB, W_GLU = 33 * MiB, W_UQ = 41 * MiB, W_UK = 44 * MiB, W_UV = 46 * MiB, W_OUT = 48 * MiB, W_GU = 56 * MiB, W_DOWN = 100 * MiB,
                 W_SC = 122 * MiB, W_SA = 134 * MiB;
constexpr size_t WS_XB = 142 * MiB, WS_SCH = 142 * MiB, WS_YG = 174 * MiB, WS_H1B = 142 * MiB;
constexpr size_t WS_UBUF = 206 * MiB, WS_CQ = 254 * MiB, WS_CKV = 270 * MiB, WS_KR = 286 * MiB, WS_G = 288 * MiB, WS_Q = 416 * MiB;
constexpr size_t WS_MIX = 206 * MiB, WS_ACT = 288 * MiB, WS_END = 512 * MiB;
constexpr int LDS_BYTES = 147456;

struct Params { const float* in[24]; float* out; unsigned char* ws; double inv_freq[32]; int use_cg; int pad; };

typedef float f32x2_t __attribute__((ext_vector_type(2)));
typedef __bf16 bf16x2_t __attribute__((ext_vector_type(2)));
__device__ __forceinline__ unsigned cvt_pk_bf16(float lo, float hi) { f32x2_t v = {lo, hi}; bf16x2_t b = __builtin_convertvector(v, bf16x2_t); return __builtin_bit_cast(unsigned, b); }
__device__ __forceinline__ float bf_lo(unsigned w) { return __uint_as_float(w << 16); }
__device__ __forceinline__ float bf_hi(unsigned w) { return __uint_as_float(w & 0xffff0000u); }
__device__ __forceinline__ u32x4 pack8(f32x4 a, f32x4 b) { u32x4 w; w.x = cvt_pk_bf16(a[0], a[1]); w.y = cvt_pk_bf16(a[2], a[3]); w.z = cvt_pk_bf16(b[0], b[1]); w.w = cvt_pk_bf16(b[2], b[3]); return w; }
__device__ __forceinline__ u32x2 pack4(f32x4 a) { u32x2 w; w.x = cvt_pk_bf16(a[0], a[1]); w.y = cvt_pk_bf16(a[2], a[3]); return w; }
__device__ __forceinline__ float sigmoidf_(float x) { return __builtin_amdgcn_rcpf(1.0f + __builtin_amdgcn_exp2f(x * -1.4426950408889634f)); }
__device__ __forceinline__ float gelu_tanh(float x) { const float y = 0.7978845608028654f * (x + 0.044715f * x * x * x); return x * __builtin_amdgcn_rcpf(1.0f + __builtin_amdgcn_exp2f(y * -2.8853900817779268f)); }
__device__ __forceinline__ float wave_sum(float v) { v += __shfl_xor(v, 1); v += __shfl_xor(v, 2); v += __shfl_xor(v, 4); v += __shfl_xor(v, 8); v += __shfl_xor(v, 16); v += __shfl_xor(v, 32); return v; }
__device__ __forceinline__ float wave_max(float v) { v = fmaxf(v, __shfl_xor(v, 1)); v = fmaxf(v, __shfl_xor(v, 2)); v = fmaxf(v, __shfl_xor(v, 4)); v = fmaxf(v, __shfl_xor(v, 8)); v = fmaxf(v, __shfl_xor(v, 16)); v = fmaxf(v, __shfl_xor(v, 32)); return v; }

constexpr int BM = 256, BK = 64, HALF = 128, HTB = HALF * BK * 2, STAGE_BYTES = 8 * HTB, NXCD = 8, WGM = 8;
struct Unit { int pm, pn; };
struct Gemm { const bf16_t* A; const bf16_t* Bt; int lda, ldb, K; };

struct StaticOrder {
    int nM, nN, nwg, G, c;
    __device__ void init(int M, int N, int G_, int c_) { nM = M / BM; nN = N / BM; nwg = nM * nN; G = G_; c = c_; }
    __device__ bool next(int i, Unit& u) const {
        const long L = (long)i * G + c; if (L >= nwg) return false;
        int wgid = (int)L; { const int q = nwg / NXCD, r = nwg % NXCD, xcd = wgid % NXCD, off = wgid / NXCD; wgid = (xcd < r ? xcd * (q + 1) : r * (q + 1) + (xcd - r) * q) + off; }
        const int nig = WGM * nN, gid = wgid / nig, fm = gid * WGM, gsz = (nM - fm) < WGM ? (nM - fm) : WGM;
        u.pm = fm + ((wgid % nig) % gsz); u.pn = (wgid % nig) / gsz; return true;
    }
};
struct ScanOrder {
    int G, c;
    __device__ bool next(int i, Unit& u) const { const int L = i * G + c; if (L >= 256) return false; u.pm = L; u.pn = L >> 2; return true; }
};

__device__ __forceinline__ int lds_byte(int r, int c) { const int st = (r >> 4) * 2 + (c >> 5), rr = r & 15, cc = c & 31, ob = rr * 64 + cc * 2; return st * 1024 + (ob ^ (((ob >> 9) & 1) << 5)); }
__device__ __forceinline__ void stage_rc(int b, int& R, int& C) { const int st = b / 1024, sb = b % 1024, swz = sb ^ (((sb >> 9) & 1) << 5); R = (st >> 1) * 16 + swz / 64; C = (st & 1) * 32 + (swz % 64) / 2; }
__device__ __forceinline__ int perm32(int rho) { const int n = rho >> 4, i = rho & 15; return 8 * (i >> 2) + 4 * n + (i & 3); }

#if !USE_MFMA_GEMM
template <class Epi, class Sched>
__device__ __forceinline__ void gemm_phase(LAS unsigned char* lds, const Gemm g, const Sched& S, const Epi& E) {
    const int tid = threadIdx.x, wid = tid >> 6, lane = tid & 63, wr = wid >> 2, wc = wid & 3, fr = lane & 15, fq = lane >> 4;
    Unit u;
    for (int ui = 0; S.next(ui, u); ++ui) {
        f32x4 acc[2][2][4][2];
#pragma unroll
        for (int a = 0; a < 2; ++a)
#pragma unroll
            for (int b = 0; b < 2; ++b)
#pragma unroll
                for (int m = 0; m < 4; ++m)
#pragma unroll
                    for (int n = 0; n < 2; ++n) acc[a][b][m][n] = (f32x4){0.f, 0.f, 0.f, 0.f};
        const bf16_t* arow = g.A + (size_t)(u.pm * 256 + wr * 64 + fr) * g.lda;
        const bf16_t* brow = g.Bt + (size_t)(u.pn * 256 + wc * 32 + fq * 8) * g.ldb;
        for (int k0 = 0; k0 < g.K; k0 += 8) {
            u32x4 aw[2][4];
#pragma unroll
            for (int ai = 0; ai < 2; ++ai)
#pragma unroll
                for (int m = 0; m < 4; ++m) aw[ai][m] = *(const u32x4*)(arow + (size_t)(ai * 128 + m * 16) * g.lda + k0);
#pragma unroll
            for (int bj = 0; bj < 2; ++bj)
#pragma unroll
                for (int n = 0; n < 2; ++n)
#pragma unroll
                    for (int e = 0; e < 4; ++e) {
                        const u32x4 w = *(const u32x4*)(brow + (size_t)(bj * 128 + n * 4 + e) * g.ldb + k0);
#pragma unroll
                        for (int ai = 0; ai < 2; ++ai)
#pragma unroll
                            for (int m = 0; m < 4; ++m) {
                                float s = acc[ai][bj][m][n][e]; const u32x4 a = aw[ai][m];
                                s = fmaf(bf_lo(a.x), bf_lo(w.x), s); s = fmaf(bf_hi(a.x), bf_hi(w.x), s); s = fmaf(bf_lo(a.y), bf_lo(w.y), s); s = fmaf(bf_hi(a.y), bf_hi(w.y), s);
                                s = fmaf(bf_lo(a.z), bf_lo(w.z), s); s = fmaf(bf_hi(a.z), bf_hi(w.z), s); s = fmaf(bf_lo(a.w), bf_lo(w.w), s); s = fmaf(bf_hi(a.w), bf_hi(w.w), s);
                                acc[ai][bj][m][n][e] = s;
                            }
                        __builtin_amdgcn_sched_barrier(0);
                    }
        }
        E(acc, u, wr, wc, fr, fq);
    }
}
#else
template <class Epi, class Sched, bool ALIGN_EPI = true, bool SP2 = true>
__device__ __forceinline__ void gemm_phase(LAS unsigned char* lds, const Gemm g, const Sched& S, const Epi& E) {
    int tid_ = threadIdx.x; asm volatile("" : "+v"(tid_));
    const int tid = tid_, wid = __builtin_amdgcn_readfirstlane(tid >> 6), lane = tid & 63, wr = wid >> 2, wc = wid & 3, fr = lane & 15, fq = lane >> 4;
    const int K = g.K, nt = K / BK;
    unsigned voffA[2], voffB[2];
#pragma unroll
    for (int i = 0; i < 2; ++i) { int R, C; stage_rc(tid * 16 + i * 8192, R, C); const int Rb = (R & ~31) + perm32(R & 31);
        voffA[i] = (unsigned)(R * g.lda + C) * 2u; voffB[i] = (unsigned)(Rb * g.ldb + C) * 2u; }
    const size_t kstep = (size_t)(BK * 2);
    const size_t hstepA = (size_t)HALF * g.lda * 2, hstepB = (size_t)HALF * g.ldb * 2;
    const size_t tstepA = 2 * hstepA, tstepB = 2 * hstepB;
    const unsigned ldsw = (unsigned)wid * 1024u;
    const int aoff = lds_byte(wr * 64 + fr, fq * 8), boff = lds_byte(wc * 32 + fr, fq * 8);
#define PG8_SA(b, h) (((b) * 2 + (h)) * HTB)
#define PG8_SB(b, h) ((4 + (b) * 2 + (h)) * HTB)
#define PG8_STAGE(bufoff, gbase, voff) do { _Pragma("unroll") for (int _i = 0; _i < 2; ++_i) \
        __builtin_amdgcn_global_load_lds((const unsigned*)((const char*)(gbase) + (voff)[_i]), (LAS unsigned*)(lds + (bufoff) + ldsw + _i * 8192), 16, 0, 0); } while (0)
#define PG8_LDA(dst, b, h) do { _Pragma("unroll") for (int m = 0; m < 4; ++m) _Pragma("unroll") for (int k = 0; k < 2; ++k) dst[m][k] = *(const LAS bf16x8*)(lds + PG8_SA(b, h) + aoff + m * 2048 + k * 1024); } while (0)
#define PG8_LDB(dst, b, h) do { _Pragma("unroll") for (int n = 0; n < 2; ++n) _Pragma("unroll") for (int k = 0; k < 2; ++k) dst[n][k] = *(const LAS bf16x8*)(lds + PG8_SB(b, h) + boff + n * 2048 + k * 1024); } while (0)
#define PG8_MMA(ai, bj, At, Bt) do { __builtin_amdgcn_s_setprio(1); _Pragma("unroll") for (int m = 0; m < 4; ++m) _Pragma("unroll") for (int n = 0; n < 2; ++n) _Pragma("unroll") for (int k = 0; k < 2; ++k) \
        acc[ai][bj][m][n] = __builtin_amdgcn_mfma_f32_16x16x32_bf16(Bt[n][k], At[m][k], acc[ai][bj][m][n], 0, 0, 0); __builtin_amdgcn_s_setprio(0); } while (0)
#define PG8_WAIT_V(n) asm volatile("s_waitcnt vmcnt(" #n ")" ::: "memory")
#define PG8_WAIT_L(n) asm volatile("s_waitcnt lgkmcnt(" #n ")" ::: "memory")
#define PG8_BAR __builtin_amdgcn_s_barrier()
#define PG8_SCHED __builtin_amdgcn_sched_barrier(0)
    Unit cur, nxt; int ui = 0;
    if (!S.next(0, cur)) return;
    f32x4 acc[2][2][4][2];
#pragma unroll
    for (int a = 0; a < 2; ++a)
#pragma unroll
        for (int b = 0; b < 2; ++b)
#pragma unroll
            for (int m = 0; m < 4; ++m)
#pragma unroll
                for (int n = 0; n < 2; ++n) acc[a][b][m][n] = (f32x4){0.f, 0.f, 0.f, 0.f};
    bf16x8 At[4][2], B0[2][2], B1[2][2];
    const char* cA = (const char*)g.A + (size_t)cur.pm * tstepA; const char* cB = (const char*)g.Bt + (size_t)cur.pn * tstepB;
    if constexpr (SP2) {
        PG8_STAGE(PG8_SB(0, 0), cB, voffB); PG8_STAGE(PG8_SB(0, 1), cB + hstepB, voffB); PG8_STAGE(PG8_SA(0, 0), cA, voffA); PG8_STAGE(PG8_SA(0, 1), cA + hstepA, voffA);
        if (wr == 1) PG8_BAR;
        PG8_WAIT_V(2); PG8_BAR;
        PG8_STAGE(PG8_SB(1, 0), cB + kstep, voffB); PG8_STAGE(PG8_SA(1, 0), cA + kstep, voffA); PG8_STAGE(PG8_SB(1, 1), cB + hstepB + kstep, voffB);
        PG8_WAIT_V(6); PG8_BAR;
    } else {
        PG8_STAGE(PG8_SB(0, 0), cB, voffB); PG8_STAGE(PG8_SA(0, 0), cA, voffA); PG8_STAGE(PG8_SB(0, 1), cB + hstepB, voffB); PG8_STAGE(PG8_SA(0, 1), cA + hstepA, voffA);
        if (wr == 1) PG8_BAR;
        PG8_WAIT_V(4); PG8_BAR;
        PG8_STAGE(PG8_SB(1, 0), cB + kstep, voffB); PG8_STAGE(PG8_SA(1, 0), cA + kstep, voffA); PG8_STAGE(PG8_SB(1, 1), cB + hstepB + kstep, voffB);
        PG8_WAIT_V(6); PG8_BAR;
    }
    for (;;) {
        const bool has_next = S.next(ui + 1, nxt);
        const char* nA = has_next ? (const char*)g.A + (size_t)nxt.pm * tstepA : cA; const char* nB = has_next ? (const char*)g.Bt + (size_t)nxt.pn * tstepB : cB;
#pragma unroll 1
        for (int t = 0; t < nt; t += 2) {
            const bool last = (t == nt - 2);
            const char* a1 = cA + (size_t)(t + 1) * kstep;
            const char* a2 = last ? nA : cA + (size_t)(t + 2) * kstep; const char* b2 = last ? nB : cB + (size_t)(t + 2) * kstep;
            const char* a3 = a2 + kstep; const char* b3 = b2 + kstep;
            if constexpr (SP2) {
            PG8_LDB(B0, 0, 0); PG8_LDB(B1, 0, 1); PG8_SCHED; PG8_LDA(At, 0, 0); PG8_STAGE(PG8_SA(1, 1), a1 + hstepA, voffA);
            PG8_WAIT_V(8); PG8_WAIT_L(0); PG8_BAR; PG8_MMA(0, 0, At, B0); PG8_MMA(0, 1, At, B1); PG8_BAR; PG8_SCHED;
            PG8_LDA(At, 0, 1); PG8_STAGE(PG8_SB(0, 0), b2, voffB); PG8_STAGE(PG8_SB(0, 1), b2 + hstepB, voffB); PG8_STAGE(PG8_SA(0, 0), a2, voffA);
            PG8_WAIT_V(8); PG8_WAIT_L(0); PG8_BAR; PG8_MMA(1, 0, At, B0); PG8_MMA(1, 1, At, B1); PG8_BAR; PG8_SCHED;
            PG8_LDB(B0, 1, 0); PG8_LDB(B1, 1, 1); PG8_SCHED; PG8_LDA(At, 1, 0); PG8_STAGE(PG8_SA(0, 1), a2 + hstepA, voffA);
            PG8_WAIT_V(8); PG8_WAIT_L(0); PG8_BAR; PG8_MMA(0, 0, At, B0); PG8_MMA(0, 1, At, B1); PG8_BAR; PG8_SCHED;
            PG8_LDA(At, 1, 1); PG8_STAGE(PG8_SB(1, 0), b3, voffB); PG8_STAGE(PG8_SB(1, 1), b3 + hstepB, voffB); PG8_STAGE(PG8_SA(1, 0), a3, voffA);
            PG8_WAIT_V(8); PG8_WAIT_L(0); PG8_BAR; PG8_MMA(1, 0, At, B0); PG8_MMA(1, 1, At, B1); PG8_BAR; PG8_SCHED;
            } else {
            PG8_LDB(B0, 0, 0); PG8_SCHED; PG8_LDA(At, 0, 0); PG8_STAGE(PG8_SA(1, 1), a1 + hstepA, voffA);
            PG8_WAIT_L(8); PG8_BAR; PG8_WAIT_L(0); PG8_MMA(0, 0, At, B0); PG8_BAR; PG8_SCHED;
            PG8_LDB(B1, 0, 1); PG8_STAGE(PG8_SB(0, 0), b2, voffB);
            PG8_BAR; PG8_WAIT_L(0); PG8_MMA(0, 1, At, B1); PG8_BAR;
            PG8_LDA(At, 0, 1); PG8_STAGE(PG8_SA(0, 0), a2, voffA);
            PG8_BAR; PG8_WAIT_L(0); PG8_MMA(1, 0, At, B0); PG8_BAR; PG8_SCHED;
            PG8_STAGE(PG8_SB(0, 1), b2 + hstepB, voffB);
            PG8_WAIT_V(6); PG8_BAR; PG8_MMA(1, 1, At, B1); PG8_BAR;
            PG8_LDB(B0, 1, 0); PG8_SCHED; PG8_LDA(At, 1, 0); PG8_STAGE(PG8_SA(0, 1), a2 + hstepA, voffA);
            PG8_WAIT_L(8); PG8_BAR; PG8_WAIT_L(0); PG8_MMA(0, 0, At, B0); PG8_BAR; PG8_SCHED;
            PG8_LDB(B1, 1, 1); PG8_STAGE(PG8_SB(1, 0), b3, voffB);
            PG8_BAR; PG8_WAIT_L(0); PG8_MMA(0, 1, At, B1); PG8_BAR;
            PG8_LDA(At, 1, 1); PG8_STAGE(PG8_SA(1, 0), a3, voffA);
            PG8_BAR; PG8_WAIT_L(0); PG8_MMA(1, 0, At, B0); PG8_BAR; PG8_SCHED;
            PG8_STAGE(PG8_SB(1, 1), b3 + hstepB, voffB);
            PG8_WAIT_V(6); PG8_BAR; PG8_MMA(1, 1, At, B1); PG8_BAR;
                    }
        }
        if constexpr (ALIGN_EPI) { if (wr == 0) PG8_BAR; }
        E(acc, cur, wr, wc, fr, fq);
        if (!has_next) break;
#pragma unroll
        for (int a = 0; a < 2; ++a)
#pragma unroll
            for (int b = 0; b < 2; ++b)
#pragma unroll
                for (int m = 0; m < 4; ++m)
#pragma unroll
                    for (int n = 0; n < 2; ++n) acc[a][b][m][n] = (f32x4){0.f, 0.f, 0.f, 0.f};
        cur = nxt; cA = nA; cB = nB; ++ui;
        if constexpr (ALIGN_EPI) { if (wr == 1) PG8_BAR; }
    }
    PG8_WAIT_V(0);
    if constexpr (!ALIGN_EPI) { if (wr == 0) PG8_BAR; }
    PG8_BAR;
#undef PG8_SA
#undef PG8_SB
#undef PG8_STAGE
#undef PG8_LDA
#undef PG8_LDB
#undef PG8_MMA
#undef PG8_WAIT_V
#undef PG8_WAIT_L
#undef PG8_BAR
#undef PG8_SCHED
}
#endif

typedef const f32x4 (&AccRef)[2][2][4][2];

struct EpiZ {
    bf16_t* ubuf; bf16_t* cq; bf16_t* ckv; bf16_t* G; bf16_t* kr; float* ssq; float* sskv; const float* cosT; const float* sinT;
    __device__ __forceinline__ void operator()(AccRef acc, const Unit& u, int wr, int wc, int fr, int fq) const {
        const int pn = u.pn;
#pragma unroll
        for (int ai = 0; ai < 2; ++ai)
#pragma unroll
            for (int m = 0; m < 4; ++m) {
                const int row = u.pm * 256 + ai * 128 + wr * 64 + m * 16 + fr;
                if (pn < 4) {
#pragma unroll
                    for (int bj = 0; bj < 2; ++bj) { const int col = pn * 256 + bj * 128 + wc * 32 + fq * 8; const int g = col >> 4, p0 = col & 15, c = row >> 4, tau = row & 15;
                        *(u32x4*)(ubuf + ((size_t)(g * 1024 + c) * 384 + tau * 16 + p0)) = pack8(acc[ai][bj][m][0], acc[ai][bj][m][1]); }
                } else if (pn < 8) {
                    bf16_t* dst = pn < 6 ? cq : ckv; float* ss = pn < 6 ? ssq : sskv; const int cb = (pn & 1) * 256; float s = 0.f;
#pragma unroll
                    for (int bj = 0; bj < 2; ++bj) { const int col = cb + bj * 128 + wc * 32 + fq * 8; const f32x4 a = acc[ai][bj][m][0], b = acc[ai][bj][m][1];
                        s += a[0] * a[0] + a[1] * a[1] + a[2] * a[2] + a[3] * a[3] + b[0] * b[0] + b[1] * b[1] + b[2] * b[2] + b[3] * b[3];
                        *(u32x4*)(dst + (size_t)row * 512 + col) = pack8(a, b); }
                    s += __shfl_xor(s, 16); s += __shfl_xor(s, 32);
                    if (fq == 0) atomicAdd(ss + row, s);
                } else if (pn < 24) {
#pragma unroll
                    for (int bj = 0; bj < 2; ++bj) { const int col = (pn - 8) * 256 + bj * 128 + wc * 32 + fq * 8; f32x4 a = acc[ai][bj][m][0], b = acc[ai][bj][m][1];
#pragma unroll
                        for (int e = 0; e < 4; ++e) { a[e] = sigmoidf_(a[e]); b[e] = sigmoidf_(b[e]); }
                        *(u32x4*)(G + (size_t)row * 4096 + col) = pack8(a, b); }
                } else {
                    if (wc < 2) { const int gi = wc * 4 + fq; const f32x4 t1 = acc[ai][0][m][0], t2 = acc[ai][0][m][1];
                        const f32x4 cs = *(const f32x4*)(cosT + (size_t)row * 32 + 4 * gi), sn = *(const f32x4*)(sinT + (size_t)row * 32 + 4 * gi);
                        const f32x4 o1 = t1 * cs - t2 * sn, o2 = t1 * sn + t2 * cs;
                        *(u32x2*)(kr + (size_t)row * 64 + 4 * gi) = pack4(o1); *(u32x2*)(kr + (size_t)row * 64 + 32 + 4 * gi) = pack4(o2); }
                }
            }
    }
};

struct EpiQ {
    bf16_t* Q; const float* ssq; const float* cosT; const float* sinT;
    __device__ __forceinline__ void operator()(AccRef acc, const Unit& u, int wr, int wc, int fr, int fq) const {
        const int pn = u.pn;
#pragma unroll
        for (int ai = 0; ai < 2; ++ai)
#pragma unroll
            for (int m = 0; m < 4; ++m) {
                const int row = u.pm * 256 + ai * 128 + wr * 64 + m * 16 + fr;
                const float rs = rsqrtf(ssq[row] * (1.0f / 512.0f) + 1e-6f) * QSCALE;
                if (pn < 8) {
#pragma unroll
                    for (int bj = 0; bj < 2; ++bj) { const int col = pn * 256 + bj * 128 + wc * 32 + fq * 8; const int h = col >> 7, d = col & 127;
                        *(u32x4*)(Q + (size_t)row * 3072 + h * 192 + d) = pack8(acc[ai][bj][m][0] * rs, acc[ai][bj][m][1] * rs); }
                } else {
#pragma unroll
                    for (int bj = 0; bj < 2; ++bj) { const int colr = (pn - 8) * 256 + bj * 128 + wc * 32 + fq * 8; const int h = colr >> 6, gi = (colr & 63) >> 3;
                        const f32x4 t1 = acc[ai][bj][m][0] * rs, t2 = acc[ai][bj][m][1] * rs;
                        const f32x4 cs = *(const f32x4*)(cosT + (size_t)row * 32 + 4 * gi), sn = *(const f32x4*)(sinT + (size_t)row * 32 + 4 * gi);
                        const f32x4 o1 = t1 * cs - t2 * sn, o2 = t1 * sn + t2 * cs;
                        bf16_t* qp = Q + (size_t)row * 3072 + h * 192 + 128 + 4 * gi;
                        *(u32x2*)(qp) = pack4(o1); *(u32x2*)(qp + 32) = pack4(o2); }
                }
            }
    }
};

struct EpiK {
    bf16_t* KN; const float* sskv;
    __device__ __forceinline__ void operator()(AccRef acc, const Unit& u, int wr, int wc, int fr, int fq) const {
#pragma unroll
        for (int ai = 0; ai < 2; ++ai)
#pragma unroll
            for (int m = 0; m < 4; ++m) {
                const int row = u.pm * 256 + ai * 128 + wr * 64 + m * 16 + fr;
                const float rs = rsqrtf(sskv[row] * (1.0f / 512.0f) + 1e-6f);
#pragma unroll
                for (int bj = 0; bj < 2; ++bj) { const int col = u.pn * 256 + bj * 128 + wc * 32 + fq * 8;
                    *(u32x4*)(KN + (size_t)row * 2048 + col) = pack8(acc[ai][bj][m][0] * rs, acc[ai][bj][m][1] * rs); }
            }
    }
};

struct EpiVT {
    bf16_t* VT; const float* sskv;
    __device__ __forceinline__ void operator()(AccRef acc, const Unit& u, int wr, int wc, int fr, int fq) const {
#pragma unroll
        for (int bj = 0; bj < 2; ++bj) {
            const int tok0 = u.pn * 256 + bj * 128 + wc * 32 + fq * 8;
            f32x4 r0 = *(const f32x4*)(sskv + tok0), r1 = *(const f32x4*)(sskv + tok0 + 4);
#pragma unroll
            for (int e = 0; e < 4; ++e) { r0[e] = rsqrtf(r0[e] * (1.0f / 512.0f) + 1e-6f); r1[e] = rsqrtf(r1[e] * (1.0f / 512.0f) + 1e-6f); }
            const int base16 = tok0 & ~15, mq = fq & 1;
#pragma unroll
            for (int ai = 0; ai < 2; ++ai)
#pragma unroll
                for (int m = 0; m < 4; ++m) {
                    const int row = u.pm * 256 + ai * 128 + wr * 64 + m * 16 + fr;
                    bf16_t* vp = VT + (size_t)row * S_ + base16;
                    *(u32x2*)(vp + 4 * (mq + 0)) = pack4(acc[ai][bj][m][0] * r0);
                    *(u32x2*)(vp + 4 * (mq + 2)) = pack4(acc[ai][bj][m][1] * r1);
                }
        }
    }
};

struct EpiSA {
    float* Sc;
    __device__ __forceinline__ void operator()(AccRef acc, const Unit& u, int wr, int wc, int fr, int fq) const {
#pragma unroll
        for (int ai = 0; ai < 2; ++ai)
#pragma unroll
            for (int m = 0; m < 4; ++m) {
                const int row = u.pm * 256 + ai * 128 + wr * 64 + m * 16 + fr;
                float* sp = Sc + (size_t)row * 128 + wc * 32 + fq * 8;
                *(f32x4*)(sp) = acc[ai][0][m][0]; *(f32x4*)(sp + 4) = acc[ai][0][m][1];
            }
    }
};

struct EpiSC {
    bf16_t* YG;
    __device__ __forceinline__ void operator()(AccRef acc, const Unit& u, int wr, int wc, int fr, int fq) const {
#pragma unroll
        for (int ai = 0; ai < 2; ++ai)
#pragma unroll
            for (int m = 0; m < 4; ++m) {
                const int row = u.pm * 256 + ai * 128 + wr * 64 + m * 16 + fr;
                const int g = row >> 10, c = row & 1023;
#pragma unroll
                for (int bj = 0; bj < 2; ++bj) { const int col = bj * 128 + wc * 32 + fq * 8; const int t = col >> 4, p0 = col & 15;
                    f32x4 a = acc[ai][bj][m][0], b = acc[ai][bj][m][1];
#pragma unroll
                    for (int e = 0; e < 4; ++e) { a[e] = gelu_tanh(a[e]); b[e] = gelu_tanh(b[e]); }
                    *(u32x4*)(YG + (size_t)(c * 16 + t) * 1024 + g * 16 + p0) = pack8(a, b); }
                __builtin_amdgcn_sched_barrier(0);
            }
    }
};

struct EpiGLU {
    bf16_t* MIX; const bf16_t* G;
    __device__ __forceinline__ void operator()(AccRef acc, const Unit& u, int wr, int wc, int fr, int fq) const {
#pragma unroll
        for (int ai = 0; ai < 2; ++ai)
#pragma unroll
            for (int m = 0; m < 4; ++m) {
                const int row = u.pm * 256 + ai * 128 + wr * 64 + m * 16 + fr;
                const int col = u.pn * 128 + wc * 32 + fq * 8;
                const u32x4 gw = __builtin_nontemporal_load((const u32x4*)(G + (size_t)row * 4096 + col));
                f32x4 a = acc[ai][0][m][0], b = acc[ai][0][m][1]; const f32x4 ga = acc[ai][1][m][0], gb = acc[ai][1][m][1];
#pragma unroll
                for (int e = 0; e < 4; ++e) { a[e] *= sigmoidf_(ga[e]); b[e] *= sigmoidf_(gb[e]); }
                a[0] *= bf_lo(gw.x); a[1] *= bf_hi(gw.x); a[2] *= bf_lo(gw.y); a[3] *= bf_hi(gw.y);
                b[0] *= bf_lo(gw.z); b[1] *= bf_hi(gw.z); b[2] *= bf_lo(gw.w); b[3] *= bf_hi(gw.w);
                *(u32x4*)(MIX + (size_t)row * 2048 + col) = pack8(a, b);
            }
    }
};

struct EpiRes {
    const float* res; float* out;
    __device__ __forceinline__ void operator()(AccRef acc, const Unit& u, int wr, int wc, int fr, int fq) const {
#pragma unroll
        for (int ai = 0; ai < 2; ++ai)
#pragma unroll
            for (int m = 0; m < 4; ++m) {
                const int row = u.pm * 256 + ai * 128 + wr * 64 + m * 16 + fr;
#pragma unroll
                for (int bj = 0; bj < 2; ++bj) { const size_t o = (size_t)row * 2048 + u.pn * 256 + bj * 128 + wc * 32 + fq * 8;
                    const f32x4 x0 = __builtin_nontemporal_load((const f32x4*)(res + o)), x1 = __builtin_nontemporal_load((const f32x4*)(res + o + 4));
                    *(f32x4*)(out + o) = x0 * ALPHA + acc[ai][bj][m][0]; *(f32x4*)(out + o + 4) = x1 * ALPHA + acc[ai][bj][m][1]; }
            }
    }
};

struct EpiResB {
    const bf16_t* res; float* out;
    __device__ __forceinline__ void operator()(AccRef acc, const Unit& u, int wr, int wc, int fr, int fq) const {
#pragma unroll
        for (int ai = 0; ai < 2; ++ai)
#pragma unroll
            for (int m = 0; m < 4; ++m) {
                const int row = u.pm * 256 + ai * 128 + wr * 64 + m * 16 + fr;
#pragma unroll
                for (int bj = 0; bj < 2; ++bj) { const size_t o = (size_t)row * 2048 + u.pn * 256 + bj * 128 + wc * 32 + fq * 8;
                    const u32x4 w = *(const u32x4*)(res + o);
                    const f32x4 x0 = {bf_lo(w.x), bf_hi(w.x), bf_lo(w.y), bf_hi(w.y)}, x1 = {bf_lo(w.z), bf_hi(w.z), bf_lo(w.w), bf_hi(w.w)};
                    *(f32x4*)(out + o) = x0 * ALPHA + acc[ai][bj][m][0]; *(f32x4*)(out + o + 4) = x1 * ALPHA + acc[ai][bj][m][1]; }
            }
    }
};

struct EpiFFN {
    bf16_t* ACT;
    __device__ __forceinline__ void operator()(AccRef acc, const Unit& u, int wr, int wc, int fr, int fq) const {
#pragma unroll
        for (int ai = 0; ai < 2; ++ai)
#pragma unroll
            for (int m = 0; m < 4; ++m) {
                const int row = u.pm * 256 + ai * 128 + wr * 64 + m * 16 + fr;
                const int col = u.pn * 128 + wc * 32 + fq * 8;
                f32x4 a = acc[ai][0][m][0], b = acc[ai][0][m][1]; const f32x4 ua = acc[ai][1][m][0], ub = acc[ai][1][m][1];
#pragma unroll
                for (int e = 0; e < 4; ++e) { a[e] = a[e] * sigmoidf_(a[e]) * ua[e]; b[e] = b[e] * sigmoidf_(b[e]) * ub[e]; }
                __builtin_nontemporal_store(pack8(a, b), (u32x4*)(ACT + (size_t)row * DFF + col));
            }
    }
};

__device__ __forceinline__ int rope_dim(int r) { const int gi = r >> 3, j = r & 7; return (j < 4) ? (4 * gi + j) : (32 + 4 * gi + (j - 4)); }

template <int WID> __device__ __forceinline__ float wsrc(const Params& p, int n, int k) {
    if (WID == 0) { const float* w = p.in[2]; if (n < 2048) return __builtin_nontemporal_load(&w[(size_t)k * 6208 + n]); if (n < 6144) return __builtin_nontemporal_load(&w[(size_t)k * 6208 + n + 64]);
        if (n < 6208) return __builtin_nontemporal_load(&w[(size_t)k * 6208 + 2048 + rope_dim(n - 6144)]); return 0.f; }
    if (WID == 1) { const float* w = p.in[11]; const int T = n >> 8, r = n & 255, bj = r >> 7, c = r & 127; return __builtin_nontemporal_load(&w[(size_t)k * 4096 + bj * 2048 + 128 * T + c]); }
    if (WID == 2) { const float* w = p.in[13]; const float gk = p.in[12][k];
        if (n < 2048) { const int h = n >> 7, d = n & 127; return __builtin_nontemporal_load(&w[(size_t)k * 3072 + h * 192 + d]) * gk; }
        const int r = n - 2048, h = r >> 6; return __builtin_nontemporal_load(&w[(size_t)k * 3072 + h * 192 + 128 + rope_dim(r & 63)]) * gk; }
    if (WID == 3) { const float* w = p.in[15]; const int h = n >> 7, d = n & 127; return __builtin_nontemporal_load(&w[(size_t)k * 4096 + h * 256 + d]) * p.in[14][k]; }
    if (WID == 4) { const float* w = p.in[15]; const int h = n >> 7, d = n & 127; return __builtin_nontemporal_load(&w[(size_t)k * 4096 + h * 256 + 128 + d]) * p.in[14][k]; }
    if (WID == 5) { return __builtin_nontemporal_load(&p.in[16][(size_t)k * 2048 + n]); }
    if (WID == 6) { const int T = n >> 8, r = n & 255, bj = r >> 7, c = r & 127; const float* w = bj ? p.in[20] : p.in[19]; return __builtin_nontemporal_load(&w[(size_t)k * DFF + 128 * T + c]); }
    return __builtin_nontemporal_load(&p.in[21][(size_t)k * 2048 + n]);
}

template <int WID> __device__ __forceinline__ void transpose_tile(const Params& p, bf16_t* Bt, int K, int tile, LAS float* sm) {
    const int tid = threadIdx.x, kT = K >> 8, tn = tile / kT, tk = tile - tn * kT, n0 = tn * 64, k0 = tk * 256;
    const int tx = tid & 63, ty = tid >> 6;
    float v[32];
#pragma unroll
    for (int i = 0; i < 32; ++i) v[i] = wsrc<WID>(p, n0 + tx, k0 + ty + 8 * i);
#pragma unroll
    for (int i = 0; i < 32; ++i) sm[(ty + 8 * i) * 65 + tx] = v[i];
    __syncthreads();
    const int j = tid >> 3, c = tid & 7;
#pragma unroll
    for (int i = 0; i < 4; ++i) {
        const int kc = c + 8 * i;
        f32x4 a, b;
#pragma unroll
        for (int e = 0; e < 4; ++e) { a[e] = sm[(8 * kc + e) * 65 + j]; b[e] = sm[(8 * kc + 4 + e) * 65 + j]; }
        *(u32x4*)(Bt + (size_t)(n0 + j) * K + k0 + 8 * kc) = pack8(a, b);
    }
    __syncthreads();
}

__device__ __forceinline__ void sincos_red(double th, float& s, float& c) {
    const double TWO_PI = 6.283185307179586476925286766559;
    th -= TWO_PI * rint(th * (1.0 / TWO_PI));
    const float t = (float)th; s = sinf(t); c = cosf(t);
}

__device__ __forceinline__ void scan_ops(const Params& p, int g, int part, LAS float* sm) {
    const int tid = threadIdx.x;
    LAS float* apr = sm;
    LAS float* api = sm + 17 * 64;
    LAS float* bbr = sm + 2176;
    LAS float* bbi = bbr + 1024;
    LAS float* cr = bbi + 1024;
    LAS float* ci = cr + 1024;
    LAS float* kl = ci + 1024;
    const float* lam_re = p.in[3] + g * 64; const float* lam_im = p.in[4] + g * 64;
    const double dt = exp((double)p.in[5][g]);
    for (int t = tid; t < 17 * 64; t += 512) {
        const int n = t & 63, k = t >> 6;
        const double lre = (double)lam_re[n], lim = (double)lam_im[n];
        const double mag = exp((double)k * lre * dt);
        float s, c; sincos_red((double)k * lim * dt, s, c);
        const double are = mag * (double)c, aim = mag * (double)s;
        apr[k * 64 + n] = (float)are; api[k * 64 + n] = (float)aim;
        if (k == 16 && part == 0) { float* aT = (float*)(p.ws + WS_AT); aT[(g * 64 + n) * 2] = (float)are; aT[(g * 64 + n) * 2 + 1] = (float)aim; }
        if (k == 1) {
            float sh, ch; sincos_red(0.5 * lim * dt, sh, ch);
            const double num_re = expm1(lre * dt) - 2.0 * mag * (double)sh * (double)sh;
            const double den = lre * lre + lim * lim;
            const double cre = (num_re * lre + aim * lim) / den, cim = (aim * lre - num_re * lim) / den;
            const float* bre = p.in[6] + (size_t)(g * 64 + n) * 16; const float* bim = p.in[7] + (size_t)(g * 64 + n) * 16;
            for (int q = 0; q < 16; ++q) { const double br = bre[q], bi = bim[q]; bbr[n * 16 + q] = (float)(cre * br - cim * bi); bbi[n * 16 + q] = (float)(cre * bi + cim * br); }
        }
    }
    for (int t = tid; t < 1024; t += 512) { cr[t] = p.in[8][(size_t)g * 1024 + t]; ci[t] = p.in[9][(size_t)g * 1024 + t]; }
    __syncthreads();
    {
        const int pi = tid >> 1, q0 = (tid & 1) * 8, L = 4 * part + 4;
        if (pi < L * 16) {
            const int lag = pi >> 4, pp = pi & 15;
            float acc8[8];
#pragma unroll
            for (int j = 0; j < 8; ++j) acc8[j] = 0.f;
            for (int n = 0; n < 64; ++n) {
                const float c_r = cr[pp * 64 + n], c_i = ci[pp * 64 + n], a_r = apr[lag * 64 + n], a_i = api[lag * 64 + n];
                const float car = c_r * a_r - c_i * a_i, cai = c_r * a_i + c_i * a_r;
                const f32x4 br0 = *(LAS const f32x4*)(bbr + n * 16 + q0), br1 = *(LAS const f32x4*)(bbr + n * 16 + q0 + 4);
                const f32x4 bi0 = *(LAS const f32x4*)(bbi + n * 16 + q0), bi1 = *(LAS const f32x4*)(bbi + n * 16 + q0 + 4);
#pragma unroll
                for (int j = 0; j < 4; ++j) { acc8[j] += car * br0[j] - cai * bi0[j]; acc8[4 + j] += car * br1[j] - cai * bi1[j]; }
            }
#pragma unroll
            for (int j = 0; j < 8; ++j) { float s = acc8[j]; if (lag == 0 && pp == q0 + j) s += p.in[10][g * 16 + pp]; kl[(lag << 8) + (pp << 4) + q0 + j] = s; }
        }
    }
    __syncthreads();
    bf16_t* wsc = (bf16_t*)(p.ws + W_SC) + (size_t)g * 256 * 384;
    for (int ch = tid; ch < 64 * 48; ch += 512) {
        const int row = 64 * part + ch / 48, c8 = (ch % 48) * 8, t = row >> 4, pp = row & 15;
        float v[8];
#pragma unroll
        for (int i = 0; i < 8; ++i) {
            const int col = c8 + i;
            if (col < 256) { const int tau = col >> 4, q = col & 15; v[i] = (tau <= t) ? kl[((t - tau) << 8) + (pp << 4) + q] : 0.f; }
            else { const int n = (col - 256) & 63, ri = (col - 256) >> 6; const float ar = apr[(t + 1) * 64 + n], ai = api[(t + 1) * 64 + n];
                v[i] = ri == 0 ? (cr[pp * 64 + n] * ar - ci[pp * 64 + n] * ai) : -(cr[pp * 64 + n] * ai + ci[pp * 64 + n] * ar); }
        }
        u32x4 w; w.x = cvt_pk_bf16(v[0], v[1]); w.y = cvt_pk_bf16(v[2], v[3]); w.z = cvt_pk_bf16(v[4], v[5]); w.w = cvt_pk_bf16(v[6], v[7]);
        *(u32x4*)(wsc + (size_t)row * 384 + c8) = w;
    }
    bf16_t* wsa = (bf16_t*)(p.ws + W_SA) + (size_t)g * 256 * 256;
    for (int ch = tid; ch < 64 * 32; ch += 512) {
        const int r6 = ch >> 5, row = (r6 < 32) ? 32 * part + r6 : 128 + 32 * part + (r6 - 32), c8 = (ch & 31) * 8;
        float v[8];
#pragma unroll
        for (int i = 0; i < 8; ++i) {
            const int col = c8 + i, tau = col >> 4, q = col & 15;
            if (row < 128) { const int ri = row >> 6, n = row & 63; const float ar = apr[(15 - tau) * 64 + n], ai = api[(15 - tau) * 64 + n];
                v[i] = ri == 0 ? (ar * bbr[n * 16 + q] - ai * bbi[n * 16 + q]) : (ar * bbi[n * 16 + q] + ai * bbr[n * 16 + q]); }
            else v[i] = 0.f;
        }
        u32x4 w; w.x = cvt_pk_bf16(v[0], v[1]); w.y = cvt_pk_bf16(v[2], v[3]); w.z = cvt_pk_bf16(v[4], v[5]); w.w = cvt_pk_bf16(v[6], v[7]);
        *(u32x4*)(wsa + (size_t)row * 256 + c8) = w;
    }
    __syncthreads();
}

constexpr int T_IN = 100 * 8, T_GLU = 64 * 4, T_UQ = 48 * 2, T_UK = 32 * 2, T_UV = 32 * 2, T_OUT = 32 * 8, T_GU = 176 * 8, T_DOWN = 32 * 22;
constexpr int T0 = T_IN, T1 = T0 + T_GLU, T2 = T1 + T_UQ, T3 = T2 + T_UK, T4 = T3 + T_UV, T5 = T4 + T_OUT, T6 = T5 + T_GU, T7 = T6 + T_DOWN;

constexpr int P0_SCAN = 256, P0_TR = P0_SCAN + T0, P0_XC = P0_TR + 2048, P0_ROPE = P0_XC + 64;
__device__ __forceinline__ void p0_prologue(const Params& p, LAS unsigned char* lds) {
    const int tid = threadIdx.x, bid = blockIdx.x, nb = gridDim.x;
    LAS float* sm = (LAS float*)lds;
    volatile LAS int* slot = (volatile LAS int*)(lds + LDS_BYTES - 32);
    unsigned char* ws = p.ws;
    unsigned* ctr = (unsigned*)(ws + WS_BAR);
    { float* z = (float*)(ws + WS_SSQ); for (int i = bid * 512 + tid; i < 2 * S_; i += nb * 512) z[i] = 0.f; }
    for (;;) {
        if (tid == 0) *slot = (int)atomicAdd(ctr, 1u);
        __syncthreads();
        const int item = *slot;
        __syncthreads();
        if (item >= P0_ROPE) break;
        if (item < P0_SCAN) scan_ops(p, item >> 2, item & 3, sm);
        else if (item < P0_TR) transpose_tile<0>(p, (bf16_t*)(ws + W_IN), 2048, item - P0_SCAN, sm);
        else if (item < P0_XC) {
            const float* x = p.in[0] + (size_t)(item - P0_TR) * 16384; bf16_t* xb = (bf16_t*)(ws + WS_XB) + (size_t)(item - P0_TR) * 16384;
            f32x4 a[4], b[4];
#pragma unroll
            for (int q = 0; q < 4; ++q) { const int o = q * 4096 + tid * 8; a[q] = __builtin_nontemporal_load((const f32x4*)(x + o)); b[q] = __builtin_nontemporal_load((const f32x4*)(x + o + 4)); }
#pragma unroll
            for (int q = 0; q < 4; ++q) { const int o = q * 4096 + tid * 8; *(u32x4*)(xb + o) = pack8(a[q], b[q]); } }
        else {
            float* cosT = (float*)(ws + WS_COS); float* sinT = (float*)(ws + WS_SIN); const int* pos = (const int*)p.in[1];
            for (int i = (item - P0_XC) * 8192 + tid; i < (item - P0_XC + 1) * 8192; i += 512) { const int t = i >> 5, f = i & 31; float s, c; sincos_red((double)pos[t] * p.inv_freq[f], s, c); cosT[i] = c; sinT[i] = s; } }
    }
}
__device__ __forceinline__ void deferred_transposes(const Params& p, LAS unsigned char* lds) {
    const int tid = threadIdx.x;
    LAS float* sm = (LAS float*)lds;
    volatile LAS int* slot = (volatile LAS int*)(lds + LDS_BYTES - 32);
    unsigned char* ws = p.ws;
    unsigned* ctr = (unsigned*)(ws + WS_BAR) + 1;
    for (;;) {
        if (tid == 0) *slot = (int)atomicAdd(ctr, 1u);
        __syncthreads();
        const int it = *slot + T0;
        __syncthreads();
        if (it >= T7) break;
        if (it < T1) transpose_tile<1>(p, (bf16_t*)(ws + W_GLU), 1024, it - T0, sm);
        else if (it < T2) transpose_tile<2>(p, (bf16_t*)(ws + W_UQ), 512, it - T1, sm);
        else if (it < T3) transpose_tile<3>(p, (bf16_t*)(ws + W_UK), 512, it - T2, sm);
        else if (it < T4) transpose_tile<4>(p, (bf16_t*)(ws + W_UV), 512, it - T3, sm);
        else if (it < T5) transpose_tile<5>(p, (bf16_t*)(ws + W_OUT), 2048, it - T4, sm);
        else if (it < T6) transpose_tile<6>(p, (bf16_t*)(ws + W_GU), 2048, it - T5, sm);
        else transpose_tile<7>(p, (bf16_t*)(ws + W_DOWN), 5632, it - T6, sm);
    }
}

__device__ __forceinline__ void carry_phase(const Params& p, LAS unsigned char* lds) {
    const int b = blockIdx.x;
    if (b >= 128) return;
    const int tid = threadIdx.x, g = b >> 1, n = 32 * (b & 1) + (tid & 31), seg = tid >> 5;
    const float* aT = (const float*)(p.ws + WS_AT);
    const float ar = aT[(g * 64 + n) * 2], ai = aT[(g * 64 + n) * 2 + 1];
    const float* Sc = (const float*)(p.ws + WS_SCH) + ((size_t)g * 1024 + 64 * seg) * 128 + n;
    bf16_t* ub = (bf16_t*)(p.ws + WS_UBUF) + ((size_t)g * 1024 + 64 * seg) * 384 + 256 + n;
    float pr[64], pi[64];
    float sr = 0.f, si = 0.f;
#pragma unroll
    for (int c0 = 0; c0 < 64; c0 += 8) {
        float vr[8], vi[8];
#pragma unroll
        for (int j = 0; j < 8; ++j) { vr[j] = Sc[(size_t)(c0 + j) * 128]; vi[j] = Sc[(size_t)(c0 + j) * 128 + 64]; }
#pragma unroll
        for (int j = 0; j < 8; ++j) { pr[c0 + j] = sr; pi[c0 + j] = si; const float nr = ar * sr - ai * si + vr[j], ni = ar * si + ai * sr + vi[j]; sr = nr; si = ni; }
    }
    LAS float* er = (LAS float*)lds;
    LAS float* ei = er + 512;
    er[seg * 32 + (tid & 31)] = sr; ei[seg * 32 + (tid & 31)] = si;
    __syncthreads();
    float a64r = ar, a64i = ai;
#pragma unroll
    for (int k = 0; k < 6; ++k) { const float t = a64r * a64r - a64i * a64i; a64i = 2.f * a64r * a64i; a64r = t; }
    float cr_ = 0.f, ci_ = 0.f;
    for (int j = 0; j < seg; ++j) { const float t = a64r * cr_ - a64i * ci_ + er[j * 32 + (tid & 31)]; ci_ = a64r * ci_ + a64i * cr_ + ei[j * 32 + (tid & 31)]; cr_ = t; }
    float wr_ = 1.f, wi_ = 0.f;
#pragma unroll
    for (int i = 0; i < 64; ++i) {
        const float s_r = pr[i] + wr_ * cr_ - wi_ * ci_, s_i = pi[i] + wr_ * ci_ + wi_ * cr_;
        ub[(size_t)i * 384] = (bf16_t)(cvt_pk_bf16(s_r, 0.f) & 0xffffu); ub[(size_t)i * 384 + 64] = (bf16_t)(cvt_pk_bf16(s_i, 0.f) & 0xffffu);
        const float t = wr_ * ar - wi_ * ai; wi_ = wr_ * ai + wi_ * ar; wr_ = t;
    }
    __syncthreads();
}

__device__ __forceinline__ void ln_phase(float* io, const float* gam, const float* bet, bf16_t* ob) {
    const int lane = threadIdx.x & 63, wid = threadIdx.x >> 6;
    for (int row = blockIdx.x * 8 + wid; row < S_; row += gridDim.x * 8) {
        float* rp = io + (size_t)row * D_;
        f32x4 v[8]; float s = 0.f;
#pragma unroll
        for (int i = 0; i < 8; ++i) { v[i] = __builtin_nontemporal_load((const f32x4*)(rp + (i * 64 + lane) * 4)); s += (v[i][0] + v[i][1]) + (v[i][2] + v[i][3]); }
        const float mu = wave_sum(s) * (1.0f / 2048.0f);
        float q = 0.f;
#pragma unroll
        for (int i = 0; i < 8; ++i) { v[i] = v[i] - mu; q += (v[i][0] * v[i][0] + v[i][1] * v[i][1]) + (v[i][2] * v[i][2] + v[i][3] * v[i][3]); }
        const float rstd = rsqrtf(wave_sum(q) * (1.0f / 2048.0f) + 1e-5f);
#pragma unroll
        for (int i = 0; i < 8; ++i) {
            const int c = (i * 64 + lane) * 4;
            const f32x4 gg = *(const f32x4*)(gam + c), bb = *(const f32x4*)(bet + c);
            const f32x4 y = v[i] * rstd * gg + bb;
            if (ob) *(u32x2*)(ob + (size_t)row * D_ + c) = pack4(y); else __builtin_nontemporal_store(y, (f32x4*)(rp + c));
        }
    }
}

__device__ __forceinline__ int tokperm(int t) { const int q = (t >> 2) & 3; const int nq = ((q & 1) << 1) | (q >> 1); return (t & ~15) | (nq << 2) | (t & 3); }

__device__ __forceinline__ void attn_naive(const Params& p, LAS unsigned char* lds) {
    const int lane = threadIdx.x & 63, wid = threadIdx.x >> 6;
    LAS float* qs = (LAS float*)lds + wid * 192;
    const bf16_t* Q = (const bf16_t*)(p.ws + WS_Q); const bf16_t* KN = (const bf16_t*)p.out; const bf16_t* VT = (const bf16_t*)p.out + (size_t)S_ * 2048;
    const bf16_t* KR = (const bf16_t*)(p.ws + WS_KR); const bf16_t* G = (const bf16_t*)(p.ws + WS_G); bf16_t* MIX = (bf16_t*)(p.ws + WS_MIX);
    const int nw = gridDim.x * 8;
    for (int u = blockIdx.x * 8 + wid; u < 16 * S_; u += nw) {
        const int h = u & 15, q = u >> 4;
        for (int d = lane; d < 192; d += 64) qs[d] = __uint_as_float((unsigned)Q[(size_t)q * 3072 + h * 192 + d] << 16);
        float o[128];
#pragma unroll
        for (int d = 0; d < 128; ++d) o[d] = 0.f;
        float mrun = -INFINITY, l = 0.f;
        for (int kc = 0; kc <= (q >> 6); ++kc) {
            const int key = kc * 64 + lane;
            float s = 0.f;
            const bf16_t* kp = KN + (size_t)key * 2048 + h * 128;
#pragma unroll 4
            for (int d8 = 0; d8 < 16; ++d8) { const u32x4 w = *(const u32x4*)(kp + d8 * 8); LAS const float* qq = qs + d8 * 8;
                s += qq[0] * bf_lo(w.x) + qq[1] * bf_hi(w.x) + qq[2] * bf_lo(w.y) + qq[3] * bf_hi(w.y) + qq[4] * bf_lo(w.z) + qq[5] * bf_hi(w.z) + qq[6] * bf_lo(w.w) + qq[7] * bf_hi(w.w); }
            const bf16_t* rp = KR + (size_t)key * 64;
#pragma unroll 4
            for (int d8 = 0; d8 < 8; ++d8) { const u32x4 w = *(const u32x4*)(rp + d8 * 8); LAS const float* qq = qs + 128 + d8 * 8;
                s += qq[0] * bf_lo(w.x) + qq[1] * bf_hi(w.x) + qq[2] * bf_lo(w.y) + qq[3] * bf_hi(w.y) + qq[4] * bf_lo(w.z) + qq[5] * bf_hi(w.z) + qq[6] * bf_lo(w.w) + qq[7] * bf_hi(w.w); }
            if (key > q) s = -INFINITY;
            const float mnew = fmaxf(mrun, wave_max(s));
            const float al = exp2f(mrun - mnew), pr = exp2f(s - mnew);
            mrun = mnew; l = l * al + pr;
            const bf16_t* vp = VT + (size_t)(h * 128) * S_ + tokperm(key);
#pragma unroll
            for (int d = 0; d < 128; ++d) o[d] = o[d] * al + pr * __uint_as_float((unsigned)vp[(size_t)d * S_] << 16);
        }
        const float linv = 1.0f / wave_sum(l);
        float r0 = 0.f, r1 = 0.f;
#pragma unroll
        for (int d = 0; d < 128; ++d) { const float t = wave_sum(o[d]); if (lane == (d & 63)) { if (d < 64) r0 = t; else r1 = t; } }
        const size_t o0 = (size_t)q * 2048 + h * 128 + lane;
        const size_t g0 = (size_t)q * 4096 + 2048 + h * 128 + lane;
        const float m0 = __uint_as_float((unsigned)MIX[o0] << 16) + __uint_as_float((unsigned)G[g0] << 16) * r0 * linv;
        const float m1 = __uint_as_float((unsigned)MIX[o0 + 64] << 16) + __uint_as_float((unsigned)G[g0 + 64] << 16) * r1 * linv;
        MIX[o0] = (bf16_t)(cvt_pk_bf16(m0, 0.f) & 0xffffu); MIX[o0 + 64] = (bf16_t)(cvt_pk_bf16(m1, 0.f) & 0xffffu);
    }
}

typedef float f32x16 __attribute__((ext_vector_type(16)));
__device__ __forceinline__ unsigned cvtpk_s(float lo, float hi) { f32x2_t v = {lo, hi}; bf16x2_t b = __builtin_convertvector(v, bf16x2_t); return __builtin_bit_cast(unsigned, b); }
constexpr int KNP = 272, KRP = 144, VP = 144;
constexpr int KNI = 64 * KNP, KRI = 64 * KRP, KBUF = KNI + KRI, VBUF = 128 * VP;
constexpr int LDS_VB = 2 * KBUF, LDS_QR = LDS_VB + 2 * VBUF;

#define ATT_KLD(kb_, hh_) do { _Pragma("unroll") for (int ks = 0; ks < 8; ++ks) kf[ks] = *(LAS const bf16x8*)((kb_) + kaddr_n + (hh_) * 32 * KNP + ks * 32); \
        _Pragma("unroll") for (int ks = 8; ks < 12; ++ks) kf[ks] = *(LAS const bf16x8*)((kb_) + kaddr_r + (hh_) * 32 * KRP + (ks - 8) * 32); } while (0)
#define ATT_QLD() do { _Pragma("unroll") for (int j = 0; j < 4; ++j) qr[j] = *(LAS const bf16x8*)(qrb + j * 32); } while (0)
#define ATT_QK() do { _Pragma("unroll") for (int r = 0; r < 16; ++r) s0[r] = 0.f; \
        _Pragma("unroll") for (int ks = 0; ks < 12; ++ks) { const bf16x8 bq = ks < 8 ? qf[ks < 8 ? ks : 0] : qr[ks < 8 ? 0 : ks - 8]; s0 = __builtin_amdgcn_mfma_f32_32x32x16_bf16(kf[ks], bq, s0, 0, 0, 0); } } while (0)
#define ATT_VLD(vb_, hh_) do { _Pragma("unroll") for (int ks = 0; ks < 2; ++ks) _Pragma("unroll") for (int b = 0; b < 4; ++b) vf[ks][b] = *(LAS const bf16x8*)((vb_) + b * 32 * VP + (hh_) * 64 + ks * 32); } while (0)
#define ATT_SOFTMAX(kbase_) do { \
        if ((kbase_) + 31 > R) { _Pragma("unroll") for (int r = 0; r < 16; ++r) { const int key = (kbase_) + (r & 3) + 8 * (r >> 2) + 4 * hl; if (key > qrow) s0[r] = -INFINITY; } } \
        float mx = s0[0]; \
        _Pragma("unroll") for (int r = 1; r < 16; ++r) mx = fmaxf(mx, s0[r]); \
        { const auto rr_ = __builtin_amdgcn_permlane32_swap(__float_as_uint(mx), __float_as_uint(mx), false, false); mx = fmaxf(__uint_as_float(rr_[0]), __uint_as_float(rr_[1])); }     \
        if (__any(mx > mrun + 8.0f)) { const float mnew = fmaxf(mrun, mx); const float alpha = __builtin_amdgcn_exp2f(mrun - mnew); mrun = mnew; lrun *= alpha; \
            _Pragma("unroll") for (int b = 0; b < 4; ++b) _Pragma("unroll") for (int r = 0; r < 16; ++r) o[b][r] *= alpha; } \
        float ps = 0.f; \
        _Pragma("unroll") for (int r = 0; r < 16; ++r) { s0[r] = __builtin_amdgcn_exp2f(s0[r] - mrun); ps += s0[r]; } \
        lrun += ps; \
        _Pragma("unroll") for (int s = 0; s < 2; ++s) { \
            pk[s].x = cvtpk_s(s0[8 * s + 0], s0[8 * s + 1]); pk[s].y = cvtpk_s(s0[8 * s + 2], s0[8 * s + 3]); pk[s].z = cvtpk_s(s0[8 * s + 4], s0[8 * s + 5]); pk[s].w = cvtpk_s(s0[8 * s + 6], s0[8 * s + 7]); } } while (0)
#define ATT_PVM() do { __builtin_amdgcn_s_setprio(1); _Pragma("unroll") for (int ks = 0; ks < 2; ++ks) { const bf16x8 pb = __builtin_bit_cast(bf16x8, pk[ks]); \
        _Pragma("unroll") for (int b = 0; b < 4; ++b) o[b] = __builtin_amdgcn_mfma_f32_32x32x16_bf16(vf[ks][b], pb, o[b], 0, 0, 0); } __builtin_amdgcn_s_setprio(0); } while (0)

template <int MODE> __device__ __forceinline__ void attn_unit(const Params& p, LAS unsigned char* lds, int h, int qb, bf16_t* MIX) {
    int tid_ = threadIdx.x; asm volatile("" : "+v"(tid_));
    const int tid = tid_, wid = __builtin_amdgcn_readfirstlane(tid >> 6), lane = tid & 63, c = lane & 31, hl = lane >> 5;
    const bf16_t* Q = (const bf16_t*)(p.ws + WS_Q); const bf16_t* KN = (const bf16_t*)p.out; const bf16_t* VT = (const bf16_t*)p.out + (size_t)S_ * 2048;
    const bf16_t* KR = (const bf16_t*)(p.ws + WS_KR); const bf16_t* G = (const bf16_t*)(p.ws + WS_G);
    const int q0 = qb * 256, R = q0 + wid * 32, qrow = R + c;
    const int nkt = 4 * (qb + 1);
    unsigned goff[6];
#pragma unroll
    for (int i = 0; i < 6; ++i) { const int j = wid + 8 * i;
        if (j < 17) { const int bo = j * 1024 + lane * 16, row = bo / KNP; int cb = bo - row * KNP; if (cb >= 256) cb = 0; goff[i] = (unsigned)((row * 2048 + h * 128) * 2 + cb); }
        else if (j < 26) { const int bo = (j - 17) * 1024 + lane * 16, row = bo / KRP; int cb = bo - row * KRP; if (cb >= 128) cb = 0; goff[i] = (unsigned)(row * 64 * 2 + cb); }
        else { const int bo = (j - 26) * 1024 + lane * 16, row = bo / VP; int cb = bo - row * VP; if (cb >= 128) cb = 0; goff[i] = (unsigned)((h * 128 + row) * S_ * 2 + cb); } }
#define ATT_DMA(kt_) do { const int b_ = (kt_) & 1; _Pragma("unroll") for (int i = 0; i < 6; ++i) { const int j = wid + 8 * i; if (j < 44) { \
            const char* gb; unsigned st; int dst; \
            if (j < 17) { gb = (const char*)KN; st = 64u * 2048u * 2u; dst = b_ * KBUF + j * 1024; } \
            else if (j < 26) { gb = (const char*)KR; st = 64u * 64u * 2u; dst = b_ * KBUF + KNI + (j - 17) * 1024; } \
            else { gb = (const char*)VT; st = 128u; dst = LDS_VB + b_ * VBUF + (j - 26) * 1024; } \
            __builtin_amdgcn_global_load_lds((const unsigned*)(gb + (goff[i] + (unsigned)(kt_) * st)), (LAS unsigned*)(lds + dst), 16, 0, 0); } } } while (0)
#define ATT_DMA_WAIT() asm volatile("s_waitcnt vmcnt(0)" ::: "memory")
    bf16x8 qf[8];
    LAS unsigned char* qrb = lds + LDS_QR + wid * (32 * VP) + c * VP + hl * 16;
    { const bf16_t* qp = Q + (size_t)qrow * 3072 + h * 192 + hl * 8;
#pragma unroll
      for (int ks = 0; ks < 8; ++ks) qf[ks] = *(const bf16x8*)(qp + ks * 16);
#pragma unroll
      for (int ks = 8; ks < 12; ++ks) *(LAS bf16x8*)(qrb + (ks - 8) * 32) = *(const bf16x8*)(qp + ks * 16); }
    f32x16 o[4];
#pragma unroll
    for (int b = 0; b < 4; ++b)
#pragma unroll
        for (int r = 0; r < 16; ++r) o[b][r] = 0.f;
    float mrun = -INFINITY, lrun = 0.f;
    u32x4 pk[2];
    ATT_DMA(0); ATT_DMA_WAIT();
    __syncthreads();
    const int kaddr_n = c * KNP + hl * 16, kaddr_r = KNI + c * KRP + hl * 16, vaddr = LDS_VB + c * VP + hl * 16;
    f32x16 s0;
#pragma unroll
    for (int ks = 0; ks < 8; ++ks) asm volatile("" :: "v"(qf[ks]));
    const int tmax = (R + 31) >> 6;
    bf16x8 kf[12], qr[4], vf[2][4];
    ATT_QLD(); ATT_KLD(lds, 0);
#pragma unroll 1
    for (int kt = 0; kt < nkt; ++kt) {
        if (!(MODE & 1)) { if (kt + 1 < nkt) ATT_DMA(kt + 1); }
        __builtin_amdgcn_sched_barrier(0);
        const int key0 = kt * 64;
        LAS const unsigned char* kb = lds + (kt & 1) * KBUF;
        LAS const unsigned char* vb = lds + (kt & 1) * VBUF + vaddr;
        const bool need = !(MODE & 2) && kt <= tmax;
        if (need) {
            __builtin_amdgcn_s_setprio(1);
            ATT_QK(); ATT_VLD(vb, 0); ATT_KLD(kb, 1);
#pragma unroll
            for (int i_ = 0; i_ < 12; ++i_) { __builtin_amdgcn_sched_group_barrier(0x008, 1, 0); __builtin_amdgcn_sched_group_barrier(0x100, 2, 0); }
            __builtin_amdgcn_s_setprio(0); __builtin_amdgcn_sched_barrier(0);
            ATT_SOFTMAX(key0); __builtin_amdgcn_sched_barrier(0);
            ATT_PVM(); __builtin_amdgcn_sched_barrier(0);
            __builtin_amdgcn_s_setprio(1);
            ATT_QK(); ATT_VLD(vb, 1);
#pragma unroll
            for (int i_ = 0; i_ < 12; ++i_) { __builtin_amdgcn_sched_group_barrier(0x008, 1, 0); __builtin_amdgcn_sched_group_barrier(0x100, 1, 0); }
            __builtin_amdgcn_s_setprio(0); __builtin_amdgcn_sched_barrier(0);
            ATT_SOFTMAX(key0 + 32); __builtin_amdgcn_sched_barrier(0);
        }
        asm volatile("s_waitcnt vmcnt(0) lgkmcnt(0)" ::: "memory");
        __syncthreads();
        if (kt + 1 <= tmax && kt + 1 < nkt) { ATT_KLD(lds + ((kt + 1) & 1) * KBUF, 0); }
        __builtin_amdgcn_sched_barrier(0);
        if (need) ATT_PVM();
    }
    __syncthreads();
#undef ATT_DMA
#undef ATT_DMA_WAIT
    { const auto rr_ = __builtin_amdgcn_permlane32_swap(__float_as_uint(lrun), __float_as_uint(lrun), false, false); lrun = __uint_as_float(rr_[0]) + __uint_as_float(rr_[1]); }
    const float inv = 1.0f / lrun;
    {
        LAS unsigned char* ow = lds + wid * (32 * 528);
#pragma unroll
        for (int b = 0; b < 4; ++b)
#pragma unroll
            for (int j = 0; j < 4; ++j) {
                const f32x4 v = {o[b][4 * j + 0] * inv, o[b][4 * j + 1] * inv, o[b][4 * j + 2] * inv, o[b][4 * j + 3] * inv};
                *(LAS f32x4*)(ow + c * 528 + (32 * b + 8 * j + 4 * hl) * 4) = v;
            }
#pragma unroll
        for (int i = 0; i < 8; ++i) {
            const int id = i * 64 + lane, row = id >> 4, cc = id & 15;
            const f32x4 a = *(LAS const f32x4*)(ow + row * 528 + cc * 32), b = *(LAS const f32x4*)(ow + row * 528 + cc * 32 + 16);
            const size_t mo = (size_t)(R + row) * 2048 + h * 128 + cc * 8, go = (size_t)(R + row) * 4096 + 2048 + h * 128 + cc * 8;
            const u32x4 mw = *(const u32x4*)(MIX + mo), gw = __builtin_nontemporal_load((const u32x4*)(G + go));
            f32x4 r0, r1;
            r0[0] = bf_lo(mw.x) + bf_lo(gw.x) * a[0]; r0[1] = bf_hi(mw.x) + bf_hi(gw.x) * a[1]; r0[2] = bf_lo(mw.y) + bf_lo(gw.y) * a[2]; r0[3] = bf_hi(mw.y) + bf_hi(gw.y) * a[3];
            r1[0] = bf_lo(mw.z) + bf_lo(gw.z) * b[0]; r1[1] = bf_hi(mw.z) + bf_hi(gw.z) * b[1]; r1[2] = bf_lo(mw.w) + bf_lo(gw.w) * b[2]; r1[3] = bf_hi(mw.w) + bf_hi(gw.w) * b[3];
            *(u32x4*)(MIX + mo) = pack8(r0, r1);
        }
    }
    __syncthreads();
}

template <int MODE> __device__ __forceinline__ void attn_phase(const Params& p, LAS unsigned char* lds, bf16_t* MIX) {
    for (int P = blockIdx.x; P < 512; P += gridDim.x) {
        const int r = P >> 8, bp = P & 255, xcd = bp & 7, slot = bp >> 3, h = xcd + 8 * r;
#pragma unroll 1
        for (int j = 0; j < 2; ++j) attn_unit<MODE>(p, lds, h, j == 0 ? 63 - slot : slot, MIX);
    }
}

#define XB_TMO      128
#define XB_XCNT(j)  (256  + 64 * (j))
#define XB_XSUB(j)  (1280 + 64 * (j))
#define XB_XGEN(j)  (2304 + 64 * (j))
#define XB_TOP      3328
#define XB_TOPGEN   3392
#define XCD_BAR_WORDS 3456
#define XB_SPIN_CAP (1u << 18)
__device__ __forceinline__ unsigned xb_ld(unsigned* p)              { return __hip_atomic_load(p, __ATOMIC_RELAXED, __HIP_MEMORY_SCOPE_AGENT); }
__device__ __forceinline__ unsigned xb_add(unsigned* p, unsigned v) { return __hip_atomic_fetch_add(p, v, __ATOMIC_RELAXED, __HIP_MEMORY_SCOPE_AGENT); }
__device__ __forceinline__ unsigned xb_xcc_id() { return (unsigned)__builtin_amdgcn_s_getreg((3 << 11) | 20) & 0xFu; }
#define XB_SPIN(cond, bar) do { unsigned _sp = 0; while (cond) { __builtin_amdgcn_s_sleep(1); \
    if ((++_sp & 255u) == 0u) { if (xb_ld(&(bar)[XB_TMO])) break; if (_sp > XB_SPIN_CAP) { atomicAdd(&(bar)[XB_TMO], 1u); break; } } } } while (0)
struct XcdBarrier { unsigned* bar; unsigned x; volatile LAS unsigned* st; };
__device__ __forceinline__ XcdBarrier xcd_barrier_post(unsigned* bar, volatile LAS unsigned* st) {
    XcdBarrier b; b.bar = bar; b.x = xb_xcc_id(); b.st = st;
    if (threadIdx.x == 0) (void)xb_add(&bar[XB_XCNT(b.x)], 1u);
    return b;
}
__device__ __forceinline__ void xcd_barrier_complete(unsigned* bar, unsigned x, unsigned& nloc, unsigned& nx) {
    const unsigned G = gridDim.x * gridDim.y * gridDim.z;
    unsigned sum, cnt, mine, sp = 0u;
    for (;;) {
        sum = 0u; cnt = 0u; mine = 0u;
#pragma unroll
        for (unsigned j = 0; j < 16; ++j) { const unsigned c = xb_ld(&bar[XB_XCNT(j)]); sum += c; cnt += (c > 0u) ? 1u : 0u; mine = (j == x) ? c : mine; }
        if (sum == G) break;
        __builtin_amdgcn_s_sleep(1);
        if ((++sp & 255u) == 0u) { if (xb_ld(&bar[XB_TMO])) break; if (sp > XB_SPIN_CAP) { atomicAdd(&bar[XB_TMO], 1u); break; } }
    }
    nloc = mine > 0u ? mine : 1u; nx = cnt > 0u ? cnt : 1u;
}
__device__ __forceinline__ void xcd_barrier(const XcdBarrier& b) {
    asm volatile("s_waitcnt vmcnt(0)" ::: "memory");
    __syncthreads();
    if (threadIdx.x == 0) {
        unsigned* bar = b.bar;
        __builtin_amdgcn_s_waitcnt(0);
        unsigned nloc = b.st[0], nx = b.st[1];
        if (nloc == 0u) { xcd_barrier_complete(bar, b.x, nloc, nx); b.st[0] = nloc; b.st[1] = nx; }
        const unsigned old = xb_add(&bar[XB_XSUB(b.x)], 1u);
        const unsigned gen = old / nloc;
        if (old + 1u == (gen + 1u) * nloc) {
            __builtin_amdgcn_fence(__ATOMIC_RELEASE, "agent");
            asm volatile("s_waitcnt vmcnt(0)" ::: "memory");
            const unsigned og = xb_add(&bar[XB_TOP], 1u);
            const unsigned tg = og / nx;
            if (og + 1u == (tg + 1u) * nx) xb_add(&bar[XB_TOPGEN], 1u);
            else XB_SPIN(xb_ld(&bar[XB_TOPGEN]) == tg, bar);
            __builtin_amdgcn_fence(__ATOMIC_ACQUIRE, "agent");
            xb_add(&bar[XB_XGEN(b.x)], 1u);
            asm volatile("s_waitcnt vmcnt(0)" ::: "memory");
        } else {
            XB_SPIN(xb_ld(&bar[XB_XGEN(b.x)]) == gen, bar);
            __builtin_amdgcn_fence(__ATOMIC_ACQUIRE, "agent");
            asm volatile("s_waitcnt vmcnt(0)" ::: "memory");
        }
    }
    __syncthreads();
}

__global__ void __launch_bounds__(512, 2) mega_fwd(Params p) {
    extern __shared__ __attribute__((aligned(16))) unsigned char lds_raw[];
    LAS unsigned char* lds = (LAS unsigned char*)lds_raw;
    cg::grid_group grid = cg::this_grid();
    volatile LAS unsigned* xb_st = (volatile LAS unsigned*)(lds + LDS_BYTES - 16);
    if (threadIdx.x == 0) { xb_st[0] = 0u; xb_st[1] = 0u; }
    __syncthreads();
    const XcdBarrier xbar = xcd_barrier_post((unsigned*)(p.ws + WS_BAR), xb_st);
    unsigned char* ws = p.ws;
    const int G = gridDim.x, bid = blockIdx.x;
    float* cosT = (float*)(ws + WS_COS); float* sinT = (float*)(ws + WS_SIN);
    float* ssq = (float*)(ws + WS_SSQ); float* sskv = (float*)(ws + WS_SSKV);
    bf16_t* KN = (bf16_t*)p.out; bf16_t* VT = (bf16_t*)p.out + (size_t)S_ * 2048;

#ifndef PM
#define PM 0xffff
#endif
#if PROBE == 100
    p0_prologue(p, lds); grid.sync();
#endif
    if (PM & 1) p0_prologue(p, lds);
    if (p.use_cg) grid.sync(); else xcd_barrier(xbar);
    if (PM & 2) {
        Gemm g{(const bf16_t*)(ws + WS_XB), (const bf16_t*)(ws + W_IN), 2048, 2048, 2048}; StaticOrder S; S.init(S_, NIN, G, bid);
        EpiZ E{(bf16_t*)(ws + WS_UBUF), (bf16_t*)(ws + WS_CQ), (bf16_t*)(ws + WS_CKV), (bf16_t*)(ws + WS_G), (bf16_t*)(ws + WS_KR), ssq, sskv, cosT, sinT};
        gemm_phase<EpiZ, StaticOrder>(lds, g, S, E);
        deferred_transposes(p, lds);
    }
    xcd_barrier(xbar);
    if (PM & 4) {
        { Gemm g{(const bf16_t*)(ws + WS_UBUF), (const bf16_t*)(ws + W_SA), 384, 256, 256}; ScanOrder S{G, bid}; EpiSA E{(float*)(ws + WS_SCH)}; gemm_phase<EpiSA, ScanOrder>(lds, g, S, E); }
        { Gemm g{(const bf16_t*)(ws + WS_CQ), (const bf16_t*)(ws + W_UQ), 512, 512, 512}; StaticOrder S; S.init(S_, 3072, G, bid); EpiQ E{(bf16_t*)(ws + WS_Q), ssq, cosT, sinT}; gemm_phase<EpiQ, StaticOrder>(lds, g, S, E); }
        { Gemm g{(const bf16_t*)(ws + WS_CKV), (const bf16_t*)(ws + W_UK), 512, 512, 512}; StaticOrder S; S.init(S_, 2048, G, bid); EpiK E{KN, sskv}; gemm_phase<EpiK, StaticOrder>(lds, g, S, E); }
        { Gemm g{(const bf16_t*)(ws + W_UV), (const bf16_t*)(ws + WS_CKV), 512, 512, 512}; StaticOrder S; S.init(2048, S_, G, bid); EpiVT E{VT, sskv}; gemm_phase<EpiVT, StaticOrder>(lds, g, S, E); }
    }
    xcd_barrier(xbar);
#if PROBE == 3
    carry_phase(p, lds); xcd_barrier(xbar);
#endif
    if (PM & 8) carry_phase(p, lds);
    xcd_barrier(xbar);
    if (PM & 16) {
        Gemm g{(const bf16_t*)(ws + WS_UBUF), (const bf16_t*)(ws + W_SC), 384, 384, 384}; ScanOrder S{G, bid}; EpiSC E{(bf16_t*)(ws + WS_YG)}; gemm_phase<EpiSC, ScanOrder>(lds, g, S, E);
    }
    xcd_barrier(xbar);
    if (PM & 32) {
        Gemm g{(const bf16_t*)(ws + WS_YG), (const bf16_t*)(ws + W_GLU), 1024, 1024, 1024}; StaticOrder S; S.init(S_, 4096, G, bid); EpiGLU E{(bf16_t*)(ws + WS_MIX), (const bf16_t*)(ws + WS_G)};
        gemm_phase<EpiGLU, StaticOrder>(lds, g, S, E);
    }
    xcd_barrier(xbar);
#if USE_MFMA_ATTN
#if PROBE == 6
    attn_phase<PROBE_MODE>(p, lds, (bf16_t*)(ws + WS_XB)); xcd_barrier(xbar);
#endif
    if (PM & 64) attn_phase<0>(p, lds, (bf16_t*)(ws + WS_MIX));
#else
    if (PM & 64) attn_naive(p, lds);
#endif
    xcd_barrier(xbar);
    if (PM & 128) {
        Gemm g{(const bf16_t*)(ws + WS_MIX), (const bf16_t*)(ws + W_OUT), 2048, 2048, 2048}; StaticOrder S; S.init(S_, 2048, G, bid); EpiRes E{p.in[0], p.out};
        gemm_phase<EpiRes, StaticOrder, false, true>(lds, g, S, E);
    }
    xcd_barrier(xbar);
    if (PM & 256) ln_phase(p.out, p.in[17], p.in[18], (bf16_t*)(ws + WS_H1B));
    xcd_barrier(xbar);
#if PROBE == 9
    { Gemm g{(const bf16_t*)(ws + WS_H1B), (const bf16_t*)(ws + W_GU), 2048, 2048, 2048}; StaticOrder S; S.init(S_, 2 * DFF, G, bid); EpiFFN E{(bf16_t*)(ws + WS_ACT)};
      gemm_phase<EpiFFN, StaticOrder>(lds, g, S, E); xcd_barrier(xbar); }
#endif
    if (PM & 512) {
        Gemm g{(const bf16_t*)(ws + WS_H1B), (const bf16_t*)(ws + W_GU), 2048, 2048, 2048}; StaticOrder S; S.init(S_, 2 * DFF, G, bid); EpiFFN E{(bf16_t*)(ws + WS_ACT)};
        gemm_phase<EpiFFN, StaticOrder>(lds, g, S, E);
    }
    xcd_barrier(xbar);
    if (PM & 1024) {
        Gemm g{(const bf16_t*)(ws + WS_ACT), (const bf16_t*)(ws + W_DOWN), DFF, DFF, DFF}; StaticOrder S; S.init(S_, 2048, G, bid); EpiResB E{(const bf16_t*)(ws + WS_H1B), p.out};
        gemm_phase<EpiResB, StaticOrder, false, true>(lds, g, S, E);
    }
    xcd_barrier(xbar);
    if (PM & 2048) ln_phase(p.out, p.in[22], p.in[23], nullptr);
}

extern "C" void kernel_launch(void* const* d_in, const int* in_sizes, int n_in, void* d_out, int out_size, void* d_ws, size_t ws_size, hipStream_t stream) {
    static int grid = 0;
    if (grid == 0) {
        if (n_in != 24 || out_size != S_ * D_ || ws_size < WS_END) { fprintf(stderr, "kernel_launch: unexpected shapes n_in %d out %d ws %zu\n", n_in, out_size, ws_size); grid = -1; return; }
        int dev = 0, cus = 0, per_cu = 0;
        hipGetDevice(&dev); hipDeviceGetAttribute(&cus, hipDeviceAttributeMultiprocessorCount, dev);
        if (hipFuncSetAttribute((const void*)mega_fwd, hipFuncAttributeMaxDynamicSharedMemorySize, LDS_BYTES) != hipSuccess) { fprintf(stderr, "kernel_launch: hipFuncSetAttribute failed\n"); grid = -1; return; }
        if (hipOccupancyMaxActiveBlocksPerMultiprocessor(&per_cu, (const void*)mega_fwd, 512, LDS_BYTES) != hipSuccess || per_cu < 1) per_cu = 1;
        (void)hipGetLastError();
        grid = cus * 1;
    }
    if (grid < 0) return;
    Params p{};
    for (int i = 0; i < 24; ++i) p.in[i] = (const float*)d_in[i];
    p.out = (float*)d_out; p.ws = (unsigned char*)d_ws;
    for (int i = 0; i < 32; ++i) p.inv_freq[i] = 1.0 / pow(10000.0, (double)(2 * i) / 64.0);
    (void)hipMemsetAsync((unsigned char*)d_ws + WS_BAR, 0, BAR_BYTES, stream);
    void* args[] = {&p};
    hipError_t e = hipLaunchCooperativeKernel((const void*)mega_fwd, dim3(grid), dim3(512), args, LDS_BYTES, stream);
    if (e != hipSuccess) fprintf(stderr, "cooperative launch failed: %s (grid %d)\n", hipGetErrorString(e), grid);
}
```

```cpp
#include <hip/hip_runtime.h>
#include <hip/hip_cooperative_groups.h>
#include <cstdio>
#include <cstdint>
#include <cmath>
namespace cg = cooperative_groups;

#ifndef PROBE
#define PROBE 0
#endif
#ifndef PROBE_MODE
#define PROBE_MODE 13
#endif
#ifndef USE_MFMA_ATTN
#define USE_MFMA_ATTN 1
#endif
#ifndef USE_MFMA_GEMM
#define USE_MFMA_GEMM 1
#endif

#define LAS __attribute__((address_space(3)))
typedef unsigned short bf16_t;
typedef short bf16x8 __attribute__((ext_vector_type(8)));
typedef float f32x4 __attribute__((ext_vector_type(4)));
typedef float f32x2 __attribute__((ext_vector_type(2)));
typedef unsigned u32x4 __attribute__((ext_vector_type(4)));
typedef unsigned u32x2 __attribute__((ext_vector_type(2)));

constexpr int S_ = 16384, D_ = 2048, NIN = 6400, DFF = 5632;
constexpr float ALPHA = 1.189207115002721f;
constexpr float QSCALE = 0.07216878364870322f * 1.4426950408889634f;
constexpr size_t MiB = 1u << 20;
constexpr size_t WS_SSQ = 0, WS_SSKV = 64 * 1024, WS_AT = 128 * 1024, WS_BAR = 256 * 1024, BAR_BYTES = 16384;
constexpr size_t WS_COS = 4 * MiB, WS_SIN = 6 * MiB;
constexpr size_t W_IN = 8 * MiB, W_GLU = 33 * MiB, W_UQ = 41 * MiB, W_UK = 44 * MiB, W_UV = 46 * MiB, W_OUT = 48 * MiB, W_GU = 56 * MiB, W_DOWN = 100 * MiB,
                 W_SC = 122 * MiB, W_SA = 134 * MiB;
constexpr size_t WS_XB = 142 * MiB, WS_SCH = 142 * MiB, WS_YG = 174 * MiB, WS_H1B = 142 * MiB;
constexpr size_t WS_UBUF = 206 * MiB, WS_CQ = 254 * MiB, WS_CKV = 270 * MiB, WS_KR = 286 * MiB, WS_G = 288 * MiB, WS_Q = 416 * MiB;
constexpr size_t WS_MIX = 206 * MiB, WS_ACT = 288 * MiB, WS_END = 512 * MiB;
constexpr int LDS_BYTES = 147456;

struct Params { const float* in[24]; float* out; unsigned char* ws; double inv_freq[32]; int use_cg; int pad; };

typedef float f32x2_t __attribute__((ext_vector_type(2)));
typedef __bf16 bf16x2_t __attribute__((ext_vector_type(2)));
__device__ __forceinline__ unsigned cvt_pk_bf16(float lo, float hi) { f32x2_t v = {lo, hi}; bf16x2_t b = __builtin_convertvector(v, bf16x2_t); return __builtin_bit_cast(unsigned, b); }
__device__ __forceinline__ float bf_lo(unsigned w) { return __uint_as_float(w << 16); }
__device__ __forceinline__ float bf_hi(unsigned w) { return __uint_as_float(w & 0xffff0000u); }
__device__ __forceinline__ u32x4 pack8(f32x4 a, f32x4 b) { u32x4 w; w.x = cvt_pk_bf16(a[0], a[1]); w.y = cvt_pk_bf16(a[2], a[3]); w.z = cvt_pk_bf16(b[0], b[1]); w.w = cvt_pk_bf16(b[2], b[3]); return w; }
__device__ __forceinline__ u32x2 pack4(f32x4 a) { u32x2 w; w.x = cvt_pk_bf16(a[0], a[1]); w.y = cvt_pk_bf16(a[2], a[3]); return w; }
__device__ __forceinline__ float sigmoidf_(float x) { return __builtin_amdgcn_rcpf(1.0f + __builtin_amdgcn_exp2f(x * -1.4426950408889634f)); }
__device__ __forceinline__ float gelu_tanh(float x) { const float y = 0.7978845608028654f * (x + 0.044715f * x * x * x); return x * __builtin_amdgcn_rcpf(1.0f + __builtin_amdgcn_exp2f(y * -2.8853900817779268f)); }
__device__ __forceinline__ float wave_sum(float v) { v += __shfl_xor(v, 1); v += __shfl_xor(v, 2); v += __shfl_xor(v, 4); v += __shfl_xor(v, 8); v += __shfl_xor(v, 16); v += __shfl_xor(v, 32); return v; }
__device__ __forceinline__ float wave_max(float v) { v = fmaxf(v, __shfl_xor(v, 1)); v = fmaxf(v, __shfl_xor(v, 2)); v = fmaxf(v, __shfl_xor(v, 4)); v = fmaxf(v, __shfl_xor(v, 8)); v = fmaxf(v, __shfl_xor(v, 16)); v = fmaxf(v, __shfl_xor(v, 32)); return v; }

constexpr int BM = 256, BK = 64, HALF = 128, HTB = HALF * BK * 2, STAGE_BYTES = 8 * HTB, NXCD = 8, WGM = 8;
struct Unit { int pm, pn; };
struct Gemm { const bf16_t* A; const bf16_t* Bt; int lda, ldb, K; };

struct StaticOrder {
    int nM, nN, nwg, G, c;
    __device__ void init(int M, int N, int G_, int c_) { nM = M / BM; nN = N / BM; nwg = nM * nN; G = G_; c = c_; }
    __device__ bool next(int i, Unit& u) const {
        const long L = (long)i * G + c; if (L >= nwg) return false;
        int wgid = (int)L; { const int q = nwg / NXCD, r = nwg % NXCD, xcd = wgid % NXCD, off = wgid / NXCD; wgid = (xcd < r ? xcd * (q + 1) : r * (q + 1) + (xcd - r) * q) + off; }
        const int nig = WGM * nN, gid = wgid / nig, fm = gid * WGM, gsz = (nM - fm) < WGM ? (nM - fm) : WGM;
        u.pm = fm + ((wgid % nig) % gsz); u.pn = (wgid % nig) / gsz; return true;
    }
};
struct ScanOrder {
    int G, c;
    __device__ bool next(int i, Unit& u) const { const int L = i * G + c; if (L >= 256) return false; u.pm = L; u.pn = L >> 2; return true; }
};

__device__ __forceinline__ int lds_byte(int r, int c) { const int st = (r >> 4) * 2 + (c >> 5), rr = r & 15, cc = c & 31, ob = rr * 64 + cc * 2; return st * 1024 + (ob ^ (((ob >> 9) & 1) << 5)); }
__device__ __forceinline__ void stage_rc(int b, int& R, int& C) { const int st = b / 1024, sb = b % 1024, swz = sb ^ (((sb >> 9) & 1) << 5); R = (st >> 1) * 16 + swz / 64; C = (st & 1) * 32 + (swz % 64) / 2; }
__device__ __forceinline__ int perm32(int rho) { const int n = rho >> 4, i = rho & 15; return 8 * (i >> 2) + 4 * n + (i & 3); }

#if !USE_MFMA_GEMM
template <class Epi, class Sched>
__device__ __forceinline__ void gemm_phase(LAS unsigned char* lds, const Gemm g, const Sched& S, const Epi& E) {
    const int tid = threadIdx.x, wid = tid >> 6, lane = tid & 63, wr = wid >> 2, wc = wid & 3, fr = lane & 15, fq = lane >> 4;
    Unit u;
    for (int ui = 0; S.next(ui, u); ++ui) {
        f32x4 acc[2][2][4][2];
#pragma unroll
        for (int a = 0; a < 2; ++a)
#pragma unroll
            for (int b = 0; b < 2; ++b)
#pragma unroll
                for (int m = 0; m < 4; ++m)
#pragma unroll
                    for (int n = 0; n < 2; ++n) acc[a][b][m][n] = (f32x4){0.f, 0.f, 0.f, 0.f};
        const bf16_t* arow = g.A + (size_t)(u.pm * 256 + wr * 64 + fr) * g.lda;
        const bf16_t* brow = g.Bt + (size_t)(u.pn * 256 + wc * 32 + fq * 8) * g.ldb;
        for (int k0 = 0; k0 < g.K; k0 += 8) {
            u32x4 aw[2][4];
#pragma unroll
            for (int ai = 0; ai < 2; ++ai)
#pragma unroll
                for (int m = 0; m < 4; ++m) aw[ai][m] = *(const u32x4*)(arow + (size_t)(ai * 128 + m * 16) * g.lda + k0);
#pragma unroll
            for (int bj = 0; bj < 2; ++bj)
#pragma unroll
                for (int n = 0; n < 2; ++n)
#pragma unroll
                    for (int e = 0; e < 4; ++e) {
                        const u32x4 w = *(const u32x4*)(brow + (size_t)(bj * 128 + n * 4 + e) * g.ldb + k0);
#pragma unroll
                        for (int ai = 0; ai < 2; ++ai)
#pragma unroll
                            for (int m = 0; m < 4; ++m) {
                                float s = acc[ai][bj][m][n][e]; const u32x4 a = aw[ai][m];
                                s = fmaf(bf_lo(a.x), bf_lo(w.x), s); s = fmaf(bf_hi(a.x), bf_hi(w.x), s); s = fmaf(bf_lo(a.y), bf_lo(w.y), s); s = fmaf(bf_hi(a.y), bf_hi(w.y), s);
                                s = fmaf(bf_lo(a.z), bf_lo(w.z), s); s = fmaf(bf_hi(a.z), bf_hi(w.z), s); s = fmaf(bf_lo(a.w), bf_lo(w.w), s); s = fmaf(bf_hi(a.w), bf_hi(w.w), s);
                                acc[ai][bj][m][n][e] = s;
                            }
                        __builtin_amdgcn_sched_barrier(0);
                    }
        }
        E(acc, u, wr, wc, fr, fq);
    }
}
#else
template <class Epi, class Sched, bool ALIGN_EPI = true, bool SP2 = true>
__device__ __forceinline__ void gemm_phase(LAS unsigned char* lds, const Gemm g, const Sched& S, const Epi& E) {
    int tid_ = threadIdx.x; asm volatile("" : "+v"(tid_));
    const int tid = tid_, wid = __builtin_amdgcn_readfirstlane(tid >> 6), lane = tid & 63, wr = wid >> 2, wc = wid & 3, fr = lane & 15, fq = lane >> 4;
    const int K = g.K, nt = K / BK;
    unsigned voffA[2], voffB[2];
#pragma unroll
    for (int i = 0; i < 2; ++i) { int R, C; stage_rc(tid * 16 + i * 8192, R, C); const int Rb = (R & ~31) + perm32(R & 31);
        voffA[i] = (unsigned)(R * g.lda + C) * 2u; voffB[i] = (unsigned)(Rb * g.ldb + C) * 2u; }
    const size_t kstep = (size_t)(BK * 2);
    const size_t hstepA = (size_t)HALF * g.lda * 2, hstepB = (size_t)HALF * g.ldb * 2;
    const size_t tstepA = 2 * hstepA, tstepB = 2 * hstepB;
    const unsigned ldsw = (unsigned)wid * 1024u;
    const int aoff = lds_byte(wr * 64 + fr, fq * 8), boff = lds_byte(wc * 32 + fr, fq * 8);
#define PG8_SA(b, h) (((b) * 2 + (h)) * HTB)
#define PG8_SB(b, h) ((4 + (b) * 2 + (h)) * HTB)
#define PG8_STAGE(bufoff, gbase, voff) do { _Pragma("unroll") for (int _i = 0; _i < 2; ++_i) \
        __builtin_amdgcn_global_load_lds((const unsigned*)((const char*)(gbase) + (voff)[_i]), (LAS unsigned*)(lds + (bufoff) + ldsw + _i * 8192), 16, 0, 0); } while (0)
#define PG8_LDA(dst, b, h) do { _Pragma("unroll") for (int m = 0; m < 4; ++m) _Pragma("unroll") for (int k = 0; k < 2; ++k) dst[m][k] = *(const LAS bf16x8*)(lds + PG8_SA(b, h) + aoff + m * 2048 + k * 1024); } while (0)
#define PG8_LDB(dst, b, h) do { _Pragma("unroll") for (int n = 0; n < 2; ++n) _Pragma("unroll") for (int k = 0; k < 2; ++k) dst[n][k] = *(const LAS bf16x8*)(lds + PG8_SB(b, h) + boff + n * 2048 + k * 1024); } while (0)
#define PG8_MMA(ai, bj, At, Bt) do { __builtin_amdgcn_s_setprio(1); _Pragma("unroll") for (int m = 0; m < 4; ++m) _Pragma("unroll") for (int n = 0; n < 2; ++n) _Pragma("unroll") for (int k = 0; k < 2; ++k) \
        acc[ai][bj][m][n] = __builtin_amdgcn_mfma_f32_16x16x32_bf16(Bt[n][k], At[m][k], acc[ai][bj][m][n], 0, 0, 0); __builtin_amdgcn_s_setprio(0); } while (0)
#define PG8_WAIT_V(n) asm volatile("s_waitcnt vmcnt(" #n ")" ::: "memory")
#define PG8_WAIT_L(n) asm volatile("s_waitcnt lgkmcnt(" #n ")" ::: "memory")
#define PG8_BAR __builtin_amdgcn_s_barrier()
#define PG8_SCHED __builtin_amdgcn_sched_barrier(0)
    Unit cur, nxt; int ui = 0;
    if (!S.next(0, cur)) return;
    f32x4 acc[2][2][4][2];
#pragma unroll
    for (int a = 0; a < 2; ++a)
#pragma unroll
        for (int b = 0; b < 2; ++b)
#pragma unroll
            for (int m = 0; m < 4; ++m)
#pragma unroll
                for (int n = 0; n < 2; ++n) acc[a][b][m][n] = (f32x4){0.f, 0.f, 0.f, 0.f};
    bf16x8 At[4][2], B0[2][2], B1[2][2];
    const char* cA = (const char*)g.A + (size_t)cur.pm * tstepA; const char* cB = (const char*)g.Bt + (size_t)cur.pn * tstepB;
    if constexpr (SP2) {
        PG8_STAGE(PG8_SB(0, 0), cB, voffB); PG8_STAGE(PG8_SB(0, 1), cB + hstepB, voffB); PG8_STAGE(PG8_SA(0, 0), cA, voffA); PG8_STAGE(PG8_SA(0, 1), cA + hstepA, voffA);
        if (wr == 1) PG8_BAR;
        PG8_WAIT_V(2); PG8_BAR;
        PG8_STAGE(PG8_SB(1, 0), cB + kstep, voffB); PG8_STAGE(PG8_SA(1, 0), cA + kstep, voffA); PG8_STAGE(PG8_SB(1, 1), cB + hstepB + kstep, voffB);
        PG8_WAIT_V(6); PG8_BAR;
    } else {
        PG8_STAGE(PG8_SB(0, 0), cB, voffB); PG8_STAGE(PG8_SA(0, 0), cA, voffA); PG8_STAGE(PG8_SB(0, 1), cB + hstepB, voffB); PG8_STAGE(PG8_SA(0, 1), cA + hstepA, voffA);
        if (wr == 1) PG8_BAR;
        PG8_WAIT_V(4); PG8_BAR;
        PG8_STAGE(PG8_SB(1, 0), cB + kstep, voffB); PG8_STAGE(PG8_SA(1, 0), cA + kstep, voffA); PG8_STAGE(PG8_SB(1, 1), cB + hstepB + kstep, voffB);
        PG8_WAIT_V(6); PG8_BAR;
    }
    for (;;) {
        const bool has_next = S.next(ui + 1, nxt);
        const char* nA = has_next ? (const char*)g.A + (size_t)nxt.pm * tstepA : cA; const char* nB = has_next ? (const char*)g.Bt + (size_t)nxt.pn * tstepB : cB;
#pragma unroll 1
        for (int t = 0; t < nt; t += 2) {
            const bool last = (t == nt - 2);
            const char* a1 = cA + (size_t)(t + 1) * kstep;
            const char* a2 = last ? nA : cA + (size_t)(t + 2) * kstep; const char* b2 = last ? nB : cB + (size_t)(t + 2) * kstep;
            const char* a3 = a2 + kstep; const char* b3 = b2 + kstep;
            if constexpr (SP2) {
            PG8_LDB(B0, 0, 0); PG8_LDB(B1, 0, 1); PG8_SCHED; PG8_LDA(At, 0, 0); PG8_STAGE(PG8_SA(1, 1), a1 + hstepA, voffA);
            PG8_WAIT_V(8); PG8_WAIT_L(0); PG8_BAR; PG8_MMA(0, 0, At, B0); PG8_MMA(0, 1, At, B1); PG8_BAR; PG8_SCHED;
            PG8_LDA(At, 0, 1); PG8_STAGE(PG8_SB(0, 0), b2, voffB); PG8_STAGE(PG8_SB(0, 1), b2 + hstepB, voffB); PG8_STAGE(PG8_SA(0, 0), a2, voffA);
            PG8_WAIT_V(8); PG8_WAIT_L(0); PG8_BAR; PG8_MMA(1, 0, At, B0); PG8_MMA(1, 1, At, B1); PG8_BAR; PG8_SCHED;
            PG8_LDB(B0, 1, 0); PG8_LDB(B1, 1, 1); PG8_SCHED; PG8_LDA(At, 1, 0); PG8_STAGE(PG8_SA(0, 1), a2 + hstepA, voffA);
            PG8_WAIT_V(8); PG8_WAIT_L(0); PG8_BAR; PG8_MMA(0, 0, At, B0); PG8_MMA(0, 1, At, B1); PG8_BAR; PG8_SCHED;
            PG8_LDA(At, 1, 1); PG8_STAGE(PG8_SB(1, 0), b3, voffB); PG8_STAGE(PG8_SB(1, 1), b3 + hstepB, voffB); PG8_STAGE(PG8_SA(1, 0), a3, voffA);
            PG8_WAIT_V(8); PG8_WAIT_L(0); PG8_BAR; PG8_MMA(1, 0, At, B0); PG8_MMA(1, 1, At, B1); PG8_BAR; PG8_SCHED;
            } else {
            PG8_LDB(B0, 0, 0); PG8_SCHED; PG8_LDA(At, 0, 0); PG8_STAGE(PG8_SA(1, 1), a1 + hstepA, voffA);
            PG8_WAIT_L(8); PG8_BAR; PG8_WAIT_L(0); PG8_MMA(0, 0, At, B0); PG8_BAR; PG8_SCHED;
            PG8_LDB(B1, 0, 1); PG8_STAGE(PG8_SB(0, 0), b2, voffB);
            PG8_BAR; PG8_WAIT_L(0); PG8_MMA(0, 1, At, B1); PG8_BAR;
            PG8_LDA(At, 0, 1); PG8_STAGE(PG8_SA(0, 0), a2, voffA);
            PG8_BAR; PG8_WAIT_L(0); PG8_MMA(1, 0, At, B0); PG8_BAR; PG8_SCHED;
            PG8_STAGE(PG8_SB(0, 1), b2 + hstepB, voffB);
            PG8_WAIT_V(6); PG8_BAR; PG8_MMA(1, 1, At, B1); PG8_BAR;
            PG8_LDB(B0, 1, 0); PG8_SCHED; PG8_LDA(At, 1, 0); PG8_STAGE(PG8_SA(0, 1), a2 + hstepA, voffA);
            PG8_WAIT_L(8); PG8_BAR; PG8_WAIT_L(0); PG8_MMA(0, 0, At, B0); PG8_BAR; PG8_SCHED;
            PG8_LDB(B1, 1, 1); PG8_STAGE(PG8_SB(1, 0), b3, voffB);
            PG8_BAR; PG8_WAIT_L(0); PG8_MMA(0, 1, At, B1); PG8_BAR;
            PG8_LDA(At, 1, 1); PG8_STAGE(PG8_SA(1, 0), a3, voffA);
            PG8_BAR; PG8_WAIT_L(0); PG8_MMA(1, 0, At, B0); PG8_BAR; PG8_SCHED;
            PG8_STAGE(PG8_SB(1, 1), b3 + hstepB, voffB);
            PG8_WAIT_V(6); PG8_BAR; PG8_MMA(1, 1, At, B1); PG8_BAR;
                    }
        }
        if constexpr (ALIGN_EPI) { if (wr == 0) PG8_BAR; }
        E(acc, cur, wr, wc, fr, fq);
        if (!has_next) break;
#pragma unroll
        for (int a = 0; a < 2; ++a)
#pragma unroll
            for (int b = 0; b < 2; ++b)
#pragma unroll
                for (int m = 0; m < 4; ++m)
#pragma unroll
                    for (int n = 0; n < 2; ++n) acc[a][b][m][n] = (f32x4){0.f, 0.f, 0.f, 0.f};
        cur = nxt; cA = nA; cB = nB; ++ui;
        if constexpr (ALIGN_EPI) { if (wr == 1) PG8_BAR; }
    }
    PG8_WAIT_V(0);
    if constexpr (!ALIGN_EPI) { if (wr == 0) PG8_BAR; }
    PG8_BAR;
#undef PG8_SA
#undef PG8_SB
#undef PG8_STAGE
#undef PG8_LDA
#undef PG8_LDB
#undef PG8_MMA
#undef PG8_WAIT_V
#undef PG8_WAIT_L
#undef PG8_BAR
#undef PG8_SCHED
}
#endif

typedef const f32x4 (&AccRef)[2][2][4][2];

struct EpiZ {
    bf16_t* ubuf; bf16_t* cq; bf16_t* ckv; bf16_t* G; bf16_t* kr; float* ssq; float* sskv; const float* cosT; const float* sinT;
    __device__ __forceinline__ void operator()(AccRef acc, const Unit& u, int wr, int wc, int fr, int fq) const {
        const int pn = u.pn;
#pragma unroll
        for (int ai = 0; ai < 2; ++ai)
#pragma unroll
            for (int m = 0; m < 4; ++m) {
                const int row = u.pm * 256 + ai * 128 + wr * 64 + m * 16 + fr;
                if (pn < 4) {
#pragma unroll
                    for (int bj = 0; bj < 2; ++bj) { const int col = pn * 256 + bj * 128 + wc * 32 + fq * 8; const int g = col >> 4, p0 = col & 15, c = row >> 4, tau = row & 15;
                        *(u32x4*)(ubuf + ((size_t)(g * 1024 + c) * 384 + tau * 16 + p0)) = pack8(acc[ai][bj][m][0], acc[ai][bj][m][1]); }
                } else if (pn < 8) {
                    bf16_t* dst = pn < 6 ? cq : ckv; float* ss = pn < 6 ? ssq : sskv; const int cb = (pn & 1) * 256; float s = 0.f;
#pragma unroll
                    for (int bj = 0; bj < 2; ++bj) { const int col = cb + bj * 128 + wc * 32 + fq * 8; const f32x4 a = acc[ai][bj][m][0], b = acc[ai][bj][m][1];
                        s += a[0] * a[0] + a[1] * a[1] + a[2] * a[2] + a[3] * a[3] + b[0] * b[0] + b[1] * b[1] + b[2] * b[2] + b[3] * b[3];
                        *(u32x4*)(dst + (size_t)row * 512 + col) = pack8(a, b); }
                    s += __shfl_xor(s, 16); s += __shfl_xor(s, 32);
                    if (fq == 0) atomicAdd(ss + row, s);
                } else if (pn < 24) {
#pragma unroll
                    for (int bj = 0; bj < 2; ++bj) { const int col = (pn - 8) * 256 + bj * 128 + wc * 32 + fq * 8; f32x4 a = acc[ai][bj][m][0], b = acc[ai][bj][m][1];
#pragma unroll
                        for (int e = 0; e < 4; ++e) { a[e] = sigmoidf_(a[e]); b[e] = sigmoidf_(b[e]); }
                        *(u32x4*)(G + (size_t)row * 4096 + col) = pack8(a, b); }
                } else {
                    if (wc < 2) { const int gi = wc * 4 + fq; const f32x4 t1 = acc[ai][0][m][0], t2 = acc[ai][0][m][1];
                        const f32x4 cs = *(const f32x4*)(cosT + (size_t)row * 32 + 4 * gi), sn = *(const f32x4*)(sinT + (size_t)row * 32 + 4 * gi);
                        const f32x4 o1 = t1 * cs - t2 * sn, o2 = t1 * sn + t2 * cs;
                        *(u32x2*)(kr + (size_t)row * 64 + 4 * gi) = pack4(o1); *(u32x2*)(kr + (size_t)row * 64 + 32 + 4 * gi) = pack4(o2); }
                }
            }
    }
};

struct EpiQ {
    bf16_t* Q; const float* ssq; const float* cosT; const float* sinT;
    __device__ __forceinline__ void operator()(AccRef acc, const Unit& u, int wr, int wc, int fr, int fq) const {
        const int pn = u.pn;
#pragma unroll
        for (int ai = 0; ai < 2; ++ai)
#pragma unroll
            for (int m = 0; m < 4; ++m) {
                const int row = u.pm * 256 + ai * 128 + wr * 64 + m * 16 + fr;
                const float rs = rsqrtf(ssq[row] * (1.0f / 512.0f) + 1e-6f) * QSCALE;
                if (pn < 8) {
#pragma unroll
                    for (int bj = 0; bj < 2; ++bj) { const int col = pn * 256 + bj * 128 + wc * 32 + fq * 8; const int h = col >> 7, d = col & 127;
                        *(u32x4*)(Q + (size_t)row * 3072 + h * 192 + d) = pack8(acc[ai][bj][m][0] * rs, acc[ai][bj][m][1] * rs); }
                } else {
#pragma unroll
                    for (int bj = 0; bj < 2; ++bj) { const int colr = (pn - 8) * 256 + bj * 128 + wc * 32 + fq * 8; const int h = colr >> 6, gi = (colr & 63) >> 3;
                        const f32x4 t1 = acc[ai][bj][m][0] * rs, t2 = acc[ai][bj][m][1] * rs;
                        const f32x4 cs = *(const f32x4*)(cosT + (size_t)row * 32 + 4 * gi), sn = *(const f32x4*)(sinT + (size_t)row * 32 + 4 * gi);
                        const f32x4 o1 = t1 * cs - t2 * sn, o2 = t1 * sn + t2 * cs;
                        bf16_t* qp = Q + (size_t)row * 3072 + h * 192 + 128 + 4 * gi;
                        *(u32x2*)(qp) = pack4(o1); *(u32x2*)(qp + 32) = pack4(o2); }
                }
            }
    }
};

struct EpiK {
    bf16_t* KN; const float* sskv;
    __device__ __forceinline__ void operator()(AccRef acc, const Unit& u, int wr, int wc, int fr, int fq) const {
#pragma unroll
        for (int ai = 0; ai < 2; ++ai)
#pragma unroll
            for (int m = 0; m < 4; ++m) {
                const int row = u.pm * 256 + ai * 128 + wr * 64 + m * 16 + fr;
                const float rs = rsqrtf(sskv[row] * (1.0f / 512.0f) + 1e-6f);
#pragma unroll
                for (int bj = 0; bj < 2; ++bj) { const int col = u.pn * 256 + bj * 128 + wc * 32 + fq * 8;
                    *(u32x4*)(KN + (size_t)row * 2048 + col) = pack8(acc[ai][bj][m][0] * rs, acc[ai][bj][m][1] * rs); }
            }
    }
};

struct EpiVT {
    bf16_t* VT; const float* sskv;
    __device__ __forceinline__ void operator()(AccRef acc, const Unit& u, int wr, int wc, int fr, int fq) const {
#pragma unroll
        for (int bj = 0; bj < 2; ++bj) {
            const int tok0 = u.pn * 256 + bj * 128 + wc * 32 + fq * 8;
            f32x4 r0 = *(const f32x4*)(sskv + tok0), r1 = *(const f32x4*)(sskv + tok0 + 4);
#pragma unroll
            for (int e = 0; e < 4; ++e) { r0[e] = rsqrtf(r0[e] * (1.0f / 512.0f) + 1e-6f); r1[e] = rsqrtf(r1[e] * (1.0f / 512.0f) + 1e-6f); }
            const int base16 = tok0 & ~15, mq = fq & 1;
#pragma unroll
            for (int ai = 0; ai < 2; ++ai)
#pragma unroll
                for (int m = 0; m < 4; ++m) {
                    const int row = u.pm * 256 + ai * 128 + wr * 64 + m * 16 + fr;
                    bf16_t* vp = VT + (size_t)row * S_ + base16;
                    *(u32x2*)(vp + 4 * (mq + 0)) = pack4(acc[ai][bj][m][0] * r0);
                    *(u32x2*)(vp + 4 * (mq + 2)) = pack4(acc[ai][bj][m][1] * r1);
                }
        }
    }
};

struct EpiSA {
    float* Sc;
    __device__ __forceinline__ void operator()(AccRef acc, const Unit& u, int wr, int wc, int fr, int fq) const {
#pragma unroll
        for (int ai = 0; ai < 2; ++ai)
#pragma unroll
            for (int m = 0; m < 4; ++m) {
                const int row = u.pm * 256 + ai * 128 + wr * 64 + m * 16 + fr;
                float* sp = Sc + (size_t)row * 128 + wc * 32 + fq * 8;
                *(f32x4*)(sp) = acc[ai][0][m][0]; *(f32x4*)(sp + 4) = acc[ai][0][m][1];
            }
    }
};

struct EpiSC {
    bf16_t* YG;
    __device__ __forceinline__ void operator()(AccRef acc, const Unit& u, int wr, int wc, int fr, int fq) const {
#pragma unroll
        for (int ai = 0; ai < 2; ++ai)
#pragma unroll
            for (int m = 0; m < 4; ++m) {
                const int row = u.pm * 256 + ai * 128 + wr * 64 + m * 16 + fr;
                const int g = row >> 10, c = row & 1023;
#pragma unroll
                for (int bj = 0; bj < 2; ++bj) { const int col = bj * 128 + wc * 32 + fq * 8; const int t = col >> 4, p0 = col & 15;
                    f32x4 a = acc[ai][bj][m][0], b = acc[ai][bj][m][1];
#pragma unroll
                    for (int e = 0; e < 4; ++e) { a[e] = gelu_tanh(a[e]); b[e] = gelu_tanh(b[e]); }
                    *(u32x4*)(YG + (size_t)(c * 16 + t) * 1024 + g * 16 + p0) = pack8(a, b); }
                __builtin_amdgcn_sched_barrier(0);
            }
    }
};

struct EpiGLU {
    bf16_t* MIX; const bf16_t* G;
    __device__ __forceinline__ void operator()(AccRef acc, const Unit& u, int wr, int wc, int fr, int fq) const {
#pragma unroll
        for (int ai = 0; ai < 2; ++ai)
#pragma unroll
            for (int m = 0; m < 4; ++m) {
                const int row = u.pm * 256 + ai * 128 + wr * 64 + m * 16 + fr;
                const int col = u.pn * 128 + wc * 32 + fq * 8;
                const u32x4 gw = __builtin_nontemporal_load((const u32x4*)(G + (size_t)row * 4096 + col));
                f32x4 a = acc[ai][0][m][0], b = acc[ai][0][m][1]; const f32x4 ga = acc[ai][1][m][0], gb = acc[ai][1][m][1];
#pragma unroll
                for (int e = 0; e < 4; ++e) { a[e] *= sigmoidf_(ga[e]); b[e] *= sigmoidf_(gb[e]); }
                a[0] *= bf_lo(gw.x); a[1] *= bf_hi(gw.x); a[2] *= bf_lo(gw.y); a[3] *= bf_hi(gw.y);
                b[0] *= bf_lo(gw.z); b[1] *= bf_hi(gw.z); b[2] *= bf_lo(gw.w); b[3] *= bf_hi(gw.w);
                *(u32x4*)(MIX + (size_t)row * 2048 + col) = pack8(a, b);
            }
    }
};

struct EpiRes {
    const float* res; float* out;
    __device__ __forceinline__ void operator()(AccRef acc, const Unit& u, int wr, int wc, int fr, int fq) const {
#pragma unroll
        for (int ai = 0; ai < 2; ++ai)
#pragma unroll
            for (int m = 0; m < 4; ++m) {
                const int row = u.pm * 256 + ai * 128 + wr * 64 + m * 16 + fr;
#pragma unroll
                for (int bj = 0; bj < 2; ++bj) { const size_t o = (size_t)row * 2048 + u.pn * 256 + bj * 128 + wc * 32 + fq * 8;
                    const f32x4 x0 = __builtin_nontemporal_load((const f32x4*)(res + o)), x1 = __builtin_nontemporal_load((const f32x4*)(res + o + 4));
                    *(f32x4*)(out + o) = x0 * ALPHA + acc[ai][bj][m][0]; *(f32x4*)(out + o + 4) = x1 * ALPHA + acc[ai][bj][m][1]; }
            }
    }
};

struct EpiResB {
    const bf16_t* res; float* out;
    __device__ __forceinline__ void operator()(AccRef acc, const Unit& u, int wr, int wc, int fr, int fq) const {
#pragma unroll
        for (int ai = 0; ai < 2; ++ai)
#pragma unroll
            for (int m = 0; m < 4; ++m) {
                const int row = u.pm * 256 + ai * 128 + wr * 64 + m * 16 + fr;
#pragma unroll
                for (int bj = 0; bj < 2; ++bj) { const size_t o = (size_t)row * 2048 + u.pn * 256 + bj * 128 + wc * 32 + fq * 8;
                    const u32x4 w = *(const u32x4*)(res + o);
                    const f32x4 x0 = {bf_lo(w.x), bf_hi(w.x), bf_lo(w.y), bf_hi(w.y)}, x1 = {bf_lo(w.z), bf_hi(w.z), bf_lo(w.w), bf_hi(w.w)};
                    *(f32x4*)(out + o) = x0 * ALPHA + acc[ai][bj][m][0]; *(f32x4*)(out + o + 4) = x1 * ALPHA + acc[ai][bj][m][1]; }
            }
    }
};

struct EpiFFN {
    bf16_t* ACT;
    __device__ __forceinline__ void operator()(AccRef acc, const Unit& u, int wr, int wc, int fr, int fq) const {
#pragma unroll
        for (int ai = 0; ai < 2; ++ai)
#pragma unroll
            for (int m = 0; m < 4; ++m) {
                const int row = u.pm * 256 + ai * 128 + wr * 64 + m * 16 + fr;
                const int col = u.pn * 128 + wc * 32 + fq * 8;
                f32x4 a = acc[ai][0][m][0], b = acc[ai][0][m][1]; const f32x4 ua = acc[ai][1][m][0], ub = acc[ai][1][m][1];
#pragma unroll
                for (int e = 0; e < 4; ++e) { a[e] = a[e] * sigmoidf_(a[e]) * ua[e]; b[e] = b[e] * sigmoidf_(b[e]) * ub[e]; }
                *(u32x4*)(ACT + (size_t)row * DFF + col) = pack8(a, b);
            }
    }
};

__device__ __forceinline__ int rope_dim(int r) { const int gi = r >> 3, j = r & 7; return (j < 4) ? (4 * gi + j) : (32 + 4 * gi + (j - 4)); }

template <int WID> __device__ __forceinline__ float wsrc(const Params& p, int n, int k) {
    if (WID == 0) { const float* w = p.in[2]; if (n < 2048) return __builtin_nontemporal_load(&w[(size_t)k * 6208 + n]); if (n < 6144) return __builtin_nontemporal_load(&w[(size_t)k * 6208 + n + 64]);
        if (n < 6208) return __builtin_nontemporal_load(&w[(size_t)k * 6208 + 2048 + rope_dim(n - 6144)]); return 0.f; }
    if (WID == 1) { const float* w = p.in[11]; const int T = n >> 8, r = n & 255, bj = r >> 7, c = r & 127; return __builtin_nontemporal_load(&w[(size_t)k * 4096 + bj * 2048 + 128 * T + c]); }
    if (WID == 2) { const float* w = p.in[13]; const float gk = p.in[12][k];
        if (n < 2048) { const int h = n >> 7, d = n & 127; return __builtin_nontemporal_load(&w[(size_t)k * 3072 + h * 192 + d]) * gk; }
        const int r = n - 2048, h = r >> 6; return __builtin_nontemporal_load(&w[(size_t)k * 3072 + h * 192 + 128 + rope_dim(r & 63)]) * gk; }
    if (WID == 3) { const float* w = p.in[15]; const int h = n >> 7, d = n & 127; return __builtin_nontemporal_load(&w[(size_t)k * 4096 + h * 256 + d]) * p.in[14][k]; }
    if (WID == 4) { const float* w = p.in[15]; const int h = n >> 7, d = n & 127; return __builtin_nontemporal_load(&w[(size_t)k * 4096 + h * 256 + 128 + d]) * p.in[14][k]; }
    if (WID == 5) { return __builtin_nontemporal_load(&p.in[16][(size_t)k * 2048 + n]); }
    if (WID == 6) { const int T = n >> 8, r = n & 255, bj = r >> 7, c = r & 127; const float* w = bj ? p.in[20] : p.in[19]; return __builtin_nontemporal_load(&w[(size_t)k * DFF + 128 * T + c]); }
    return __builtin_nontemporal_load(&p.in[21][(size_t)k * 2048 + n]);
}

template <int WID> __device__ __forceinline__ void transpose_tile(const Params& p, bf16_t* Bt, int K, int tile, LAS float* sm) {
    const int tid = threadIdx.x, kT = K >> 8, tn = tile / kT, tk = tile - tn * kT, n0 = tn * 64, k0 = tk * 256;
    const int tx = tid & 63, ty = tid >> 6;
    float v[32];
#pragma unroll
    for (int i = 0; i < 32; ++i) v[i] = wsrc<WID>(p, n0 + tx, k0 + ty + 8 * i);
#pragma unroll
    for (int i = 0; i < 32; ++i) sm[(ty + 8 * i) * 65 + tx] = v[i];
    __syncthreads();
    const int j = tid >> 3, c = tid & 7;
#pragma unroll
    for (int i = 0; i < 4; ++i) {
        const int kc = c + 8 * i;
        f32x4 a, b;
#pragma unroll
        for (int e = 0; e < 4; ++e) { a[e] = sm[(8 * kc + e) * 65 + j]; b[e] = sm[(8 * kc + 4 + e) * 65 + j]; }
        *(u32x4*)(Bt + (size_t)(n0 + j) * K + k0 + 8 * kc) = pack8(a, b);
    }
    __syncthreads();
}

__device__ __forceinline__ void sincos_red(double th, float& s, float& c) {
    const double TWO_PI = 6.283185307179586476925286766559;
    th -= TWO_PI * rint(th * (1.0 / TWO_PI));
    const float t = (float)th; s = sinf(t); c = cosf(t);
}

__device__ __forceinline__ void scan_ops(const Params& p, int g, int part, LAS float* sm) {
    const int tid = threadIdx.x;
    LAS float* apr = sm;
    LAS float* api = sm + 17 * 64;
    LAS float* bbr = sm + 2176;
    LAS float* bbi = bbr + 1024;
    LAS float* cr = bbi + 1024;
    LAS float* ci = cr + 1024;
    LAS float* kl = ci + 1024;
    const float* lam_re = p.in[3] + g * 64; const float* lam_im = p.in[4] + g * 64;
    const double dt = exp((double)p.in[5][g]);
    for (int t = tid; t < 17 * 64; t += 512) {
        const int n = t & 63, k = t >> 6;
        const double lre = (double)lam_re[n], lim = (double)lam_im[n];
        const double mag = exp((double)k * lre * dt);
        float s, c; sincos_red((double)k * lim * dt, s, c);
        const double are = mag * (double)c, aim = mag * (double)s;
        apr[k * 64 + n] = (float)are; api[k * 64 + n] = (float)aim;
        if (k == 16 && part == 0) { float* aT = (float*)(p.ws + WS_AT); aT[(g * 64 + n) * 2] = (float)are; aT[(g * 64 + n) * 2 + 1] = (float)aim; }
        if (k == 1) {
            float sh, ch; sincos_red(0.5 * lim * dt, sh, ch);
            const double num_re = expm1(lre * dt) - 2.0 * mag * (double)sh * (double)sh;
            const double den = lre * lre + lim * lim;
            const double cre = (num_re * lre + aim * lim) / den, cim = (aim * lre - num_re * lim) / den;
            const float* bre = p.in[6] + (size_t)(g * 64 + n) * 16; const float* bim = p.in[7] + (size_t)(g * 64 + n) * 16;
            for (int q = 0; q < 16; ++q) { const double br = bre[q], bi = bim[q]; bbr[n * 16 + q] = (float)(cre * br - cim * bi); bbi[n * 16 + q] = (float)(cre * bi + cim * br); }
        }
    }
    for (int t = tid; t < 1024; t += 512) { cr[t] = p.in[8][(size_t)g * 1024 + t]; ci[t] = p.in[9][(size_t)g * 1024 + t]; }
    __syncthreads();
    {
        const int pi = tid >> 1, q0 = (tid & 1) * 8, L = 4 * part + 4;
        if (pi < L * 16) {
            const int lag = pi >> 4, pp = pi & 15;
            float acc8[8];
#pragma unroll
            for (int j = 0; j < 8; ++j) acc8[j] = 0.f;
            for (int n = 0; n < 64; ++n) {
                const float c_r = cr[pp * 64 + n], c_i = ci[pp * 64 + n], a_r = apr[lag * 64 + n], a_i = api[lag * 64 + n];
                const float car = c_r * a_r - c_i * a_i, cai = c_r * a_i + c_i * a_r;
                const f32x4 br0 = *(LAS const f32x4*)(bbr + n * 16 + q0), br1 = *(LAS const f32x4*)(bbr + n * 16 + q0 + 4);
                const f32x4 bi0 = *(LAS const f32x4*)(bbi + n * 16 + q0), bi1 = *(LAS const f32x4*)(bbi + n * 16 + q0 + 4);
#pragma unroll
                for (int j = 0; j < 4; ++j) { acc8[j] += car * br0[j] - cai * bi0[j]; acc8[4 + j] += car * br1[j] - cai * bi1[j]; }
            }
#pragma unroll
            for (int j = 0; j < 8; ++j) { float s = acc8[j]; if (lag == 0 && pp == q0 + j) s += p.in[10][g * 16 + pp]; kl[(lag << 8) + (pp << 4) + q0 + j] = s; }
        }
    }
    __syncthreads();
    bf16_t* wsc = (bf16_t*)(p.ws + W_SC) + (size_t)g * 256 * 384;
    for (int ch = tid; ch < 64 * 48; ch += 512) {
        const int row = 64 * part + ch / 48, c8 = (ch % 48) * 8, t = row >> 4, pp = row & 15;
        float v[8];
#pragma unroll
        for (int i = 0; i < 8; ++i) {
            const int col = c8 + i;
            if (col < 256) { const int tau = col >> 4, q = col & 15; v[i] = (tau <= t) ? kl[((t - tau) << 8) + (pp << 4) + q] : 0.f; }
            else { const int n = (col - 256) & 63, ri = (col - 256) >> 6; const float ar = apr[(t + 1) * 64 + n], ai = api[(t + 1) * 64 + n];
                v[i] = ri == 0 ? (cr[pp * 64 + n] * ar - ci[pp * 64 + n] * ai) : -(cr[pp * 64 + n] * ai + ci[pp * 64 + n] * ar); }
        }
        u32x4 w; w.x = cvt_pk_bf16(v[0], v[1]); w.y = cvt_pk_bf16(v[2], v[3]); w.z = cvt_pk_bf16(v[4], v[5]); w.w = cvt_pk_bf16(v[6], v[7]);
        *(u32x4*)(wsc + (size_t)row * 384 + c8) = w;
    }
    bf16_t* wsa = (bf16_t*)(p.ws + W_SA) + (size_t)g * 256 * 256;
    for (int ch = tid; ch < 64 * 32; ch += 512) {
        const int r6 = ch >> 5, row = (r6 < 32) ? 32 * part + r6 : 128 + 32 * part + (r6 - 32), c8 = (ch & 31) * 8;
        float v[8];
#pragma unroll
        for (int i = 0; i < 8; ++i) {
            const int col = c8 + i, tau = col >> 4, q = col & 15;
            if (row < 128) { const int ri = row >> 6, n = row & 63; const float ar = apr[(15 - tau) * 64 + n], ai = api[(15 - tau) * 64 + n];
                v[i] = ri == 0 ? (ar * bbr[n * 16 + q] - ai * bbi[n * 16 + q]) : (ar * bbi[n * 16 + q] + ai * bbr[n * 16 + q]); }
            else v[i] = 0.f;
        }
        u32x4 w; w.x = cvt_pk_bf16(v[0], v[1]); w.y = cvt_pk_bf16(v[2], v[3]); w.z = cvt_pk_bf16(v[4], v[5]); w.w = cvt_pk_bf16(v[6], v[7]);
        *(u32x4*)(wsa + (size_t)row * 256 + c8) = w;
    }
    __syncthreads();
}

constexpr int T_IN = 100 * 8, T_GLU = 64 * 4, T_UQ = 48 * 2, T_UK = 32 * 2, T_UV = 32 * 2, T_OUT = 32 * 8, T_GU = 176 * 8, T_DOWN = 32 * 22;
constexpr int T0 = T_IN, T1 = T0 + T_GLU, T2 = T1 + T_UQ, T3 = T2 + T_UK, T4 = T3 + T_UV, T5 = T4 + T_OUT, T6 = T5 + T_GU, T7 = T6 + T_DOWN;

constexpr int P0_SCAN = 256, P0_TR = P0_SCAN + T0, P0_XC = P0_TR + 2048, P0_ROPE = P0_XC + 64;
__device__ __forceinline__ void p0_prologue(const Params& p, LAS unsigned char* lds) {
    const int tid = threadIdx.x, bid = blockIdx.x, nb = gridDim.x;
    LAS float* sm = (LAS float*)lds;
    volatile LAS int* slot = (volatile LAS int*)(lds + LDS_BYTES - 32);
    unsigned char* ws = p.ws;
    unsigned* ctr = (unsigned*)(ws + WS_BAR);
    { float* z = (float*)(ws + WS_SSQ); for (int i = bid * 512 + tid; i < 2 * S_; i += nb * 512) z[i] = 0.f; }
    for (;;) {
        if (tid == 0) *slot = (int)atomicAdd(ctr, 1u);
        __syncthreads();
        const int item = *slot;
        __syncthreads();
        if (item >= P0_ROPE) break;
        if (item < P0_SCAN) scan_ops(p, item >> 2, item & 3, sm);
        else if (item < P0_TR) transpose_tile<0>(p, (bf16_t*)(ws + W_IN), 2048, item - P0_SCAN, sm);
        else if (item < P0_XC) {
            const float* x = p.in[0] + (size_t)(item - P0_TR) * 16384; bf16_t* xb = (bf16_t*)(ws + WS_XB) + (size_t)(item - P0_TR) * 16384;
            f32x4 a[4], b[4];
#pragma unroll
            for (int q = 0; q < 4; ++q) { const int o = q * 4096 + tid * 8; a[q] = __builtin_nontemporal_load((const f32x4*)(x + o)); b[q] = __builtin_nontemporal_load((const f32x4*)(x + o + 4)); }
#pragma unroll
            for (int q = 0; q < 4; ++q) { const int o = q * 4096 + tid * 8; *(u32x4*)(xb + o) = pack8(a[q], b[q]); } }
        else {
            float* cosT = (float*)(ws + WS_COS); float* sinT = (float*)(ws + WS_SIN); const int* pos = (const int*)p.in[1];
            for (int i = (item - P0_XC) * 8192 + tid; i < (item - P0_XC + 1) * 8192; i += 512) { const int t = i >> 5, f = i & 31; float s, c; sincos_red((double)pos[t] * p.inv_freq[f], s, c); cosT[i] = c; sinT[i] = s; } }
    }
}
__device__ __forceinline__ void deferred_transposes(const Params& p, LAS unsigned char* lds) {
    const int tid = threadIdx.x;
    LAS float* sm = (LAS float*)lds;
    volatile LAS int* slot = (volatile LAS int*)(lds + LDS_BYTES - 32);
    unsigned char* ws = p.ws;
    unsigned* ctr = (unsigned*)(ws + WS_BAR) + 1;
    for (;;) {
        if (tid == 0) *slot = (int)atomicAdd(ctr, 1u);
        __syncthreads();
        const int it = *slot + T0;
        __syncthreads();
        if (it >= T7) break;
        if (it < T1) transpose_tile<1>(p, (bf16_t*)(ws + W_GLU), 1024, it - T0, sm);
        else if (it < T2) transpose_tile<2>(p, (bf16_t*)(ws + W_UQ), 512, it - T1, sm);
        else if (it < T3) transpose_tile<3>(p, (bf16_t*)(ws + W_UK), 512, it - T2, sm);
        else if (it < T4) transpose_tile<4>(p, (bf16_t*)(ws + W_UV), 512, it - T3, sm);
        else if (it < T5) transpose_tile<5>(p, (bf16_t*)(ws + W_OUT), 2048, it - T4, sm);
        else if (it < T6) transpose_tile<6>(p, (bf16_t*)(ws + W_GU), 2048, it - T5, sm);
        else transpose_tile<7>(p, (bf16_t*)(ws + W_DOWN), 5632, it - T6, sm);
    }
}

__device__ __forceinline__ void carry_phase(const Params& p, LAS unsigned char* lds) {
    const int b = blockIdx.x;
    if (b >= 128) return;
    const int tid = threadIdx.x, g = b >> 1, n = 32 * (b & 1) + (tid & 31), seg = tid >> 5;
    const float* aT = (const float*)(p.ws + WS_AT);
    const float ar = aT[(g * 64 + n) * 2], ai = aT[(g * 64 + n) * 2 + 1];
    const float* Sc = (const float*)(p.ws + WS_SCH) + ((size_t)g * 1024 + 64 * seg) * 128 + n;
    bf16_t* ub = (bf16_t*)(p.ws + WS_UBUF) + ((size_t)g * 1024 + 64 * seg) * 384 + 256 + n;
    float pr[64], pi[64];
    float sr = 0.f, si = 0.f;
#pragma unroll
    for (int c0 = 0; c0 < 64; c0 += 8) {
        float vr[8], vi[8];
#pragma unroll
        for (int j = 0; j < 8; ++j) { vr[j] = Sc[(size_t)(c0 + j) * 128]; vi[j] = Sc[(size_t)(c0 + j) * 128 + 64]; }
#pragma unroll
        for (int j = 0; j < 8; ++j) { pr[c0 + j] = sr; pi[c0 + j] = si; const float nr = ar * sr - ai * si + vr[j], ni = ar * si + ai * sr + vi[j]; sr = nr; si = ni; }
    }
    LAS float* er = (LAS float*)lds;
    LAS float* ei = er + 512;
    er[seg * 32 + (tid & 31)] = sr; ei[seg * 32 + (tid & 31)] = si;
    __syncthreads();
    float a64r = ar, a64i = ai;
#pragma unroll
    for (int k = 0; k < 6; ++k) { const float t = a64r * a64r - a64i * a64i; a64i = 2.f * a64r * a64i; a64r = t; }
    float cr_ = 0.f, ci_ = 0.f;
    for (int j = 0; j < seg; ++j) { const float t = a64r * cr_ - a64i * ci_ + er[j * 32 + (tid & 31)]; ci_ = a64r * ci_ + a64i * cr_ + ei[j * 32 + (tid & 31)]; cr_ = t; }
    float wr_ = 1.f, wi_ = 0.f;
#pragma unroll
    for (int i = 0; i < 64; ++i) {
        const float s_r = pr[i] + wr_ * cr_ - wi_ * ci_, s_i = pi[i] + wr_ * ci_ + wi_ * cr_;
        ub[(size_t)i * 384] = (bf16_t)(cvt_pk_bf16(s_r, 0.f) & 0xffffu); ub[(size_t)i * 384 + 64] = (bf16_t)(cvt_pk_bf16(s_i, 0.f) & 0xffffu);
        const float t = wr_ * ar - wi_ * ai; wi_ = wr_ * ai + wi_ * ar; wr_ = t;
    }
    __syncthreads();
}

__device__ __forceinline__ void ln_row(f32x4 (&v)[8], float* rp, int row, const float* gam, const float* bet, bf16_t* ob, int lane) {
    float s = 0.f;
#pragma unroll
    for (int i = 0; i < 8; ++i) s += (v[i][0] + v[i][1]) + (v[i][2] + v[i][3]);
    const float mu = wave_sum(s) * (1.0f / 2048.0f);
    float q = 0.f;
#pragma unroll
    for (int i = 0; i < 8; ++i) { v[i] = v[i] - mu; q += (v[i][0] * v[i][0] + v[i][1] * v[i][1]) + (v[i][2] * v[i][2] + v[i][3] * v[i][3]); }
    const float rstd = rsqrtf(wave_sum(q) * (1.0f / 2048.0f) + 1e-5f);
#pragma unroll
    for (int i = 0; i < 8; ++i) {
        const int c = (i * 64 + lane) * 4;
        const f32x4 gg = *(const f32x4*)(gam + c), bb = *(const f32x4*)(bet + c);
        const f32x4 y = v[i] * rstd * gg + bb;
        if (ob) *(u32x2*)(ob + (size_t)row * D_ + c) = pack4(y); else __builtin_nontemporal_store(y, (f32x4*)(rp + c));
    }
}
__device__ __forceinline__ void ln_phase(float* io, const float* gam, const float* bet, bf16_t* ob) {
    const int lane = threadIdx.x & 63, wid = threadIdx.x >> 6;
    const int stride = gridDim.x * 8;
    for (int row = blockIdx.x * 8 + wid; row < S_; row += 2 * stride) {
        const int row2 = row + stride; const bool has2 = row2 < S_;
        float* rp = io + (size_t)row * D_; float* rq = io + (size_t)(has2 ? row2 : row) * D_;
        f32x4 v[8], w[8];
#pragma unroll
        for (int i = 0; i < 8; ++i) v[i] = __builtin_nontemporal_load((const f32x4*)(rp + (i * 64 + lane) * 4));
#pragma unroll
        for (int i = 0; i < 8; ++i) w[i] = __builtin_nontemporal_load((const f32x4*)(rq + (i * 64 + lane) * 4));
        ln_row(v, rp, row, gam, bet, ob, lane);
        if (has2) ln_row(w, rq, row2, gam, bet, ob, lane);
    }
}

__device__ __forceinline__ int tokperm(int t) { const int q = (t >> 2) & 3; const int nq = ((q & 1) << 1) | (q >> 1); return (t & ~15) | (nq << 2) | (t & 3); }

__device__ __forceinline__ void attn_naive(const Params& p, LAS unsigned char* lds) {
    const int lane = threadIdx.x & 63, wid = threadIdx.x >> 6;
    LAS float* qs = (LAS float*)lds + wid * 192;
    const bf16_t* Q = (const bf16_t*)(p.ws + WS_Q); const bf16_t* KN = (const bf16_t*)p.out; const bf16_t* VT = (const bf16_t*)p.out + (size_t)S_ * 2048;
    const bf16_t* KR = (const bf16_t*)(p.ws + WS_KR); const bf16_t* G = (const bf16_t*)(p.ws + WS_G); bf16_t* MIX = (bf16_t*)(p.ws + WS_MIX);
    const int nw = gridDim.x * 8;
    for (int u = blockIdx.x * 8 + wid; u < 16 * S_; u += nw) {
        const int h = u & 15, q = u >> 4;
        for (int d = lane; d < 192; d += 64) qs[d] = __uint_as_float((unsigned)Q[(size_t)q * 3072 + h * 192 + d] << 16);
        float o[128];
#pragma unroll
        for (int d = 0; d < 128; ++d) o[d] = 0.f;
        float mrun = -INFINITY, l = 0.f;
        for (int kc = 0; kc <= (q >> 6); ++kc) {
            const int key = kc * 64 + lane;
            float s = 0.f;
            const bf16_t* kp = KN + (size_t)key * 2048 + h * 128;
#pragma unroll 4
            for (int d8 = 0; d8 < 16; ++d8) { const u32x4 w = *(const u32x4*)(kp + d8 * 8); LAS const float* qq = qs + d8 * 8;
                s += qq[0] * bf_lo(w.x) + qq[1] * bf_hi(w.x) + qq[2] * bf_lo(w.y) + qq[3] * bf_hi(w.y) + qq[4] * bf_lo(w.z) + qq[5] * bf_hi(w.z) + qq[6] * bf_lo(w.w) + qq[7] * bf_hi(w.w); }
            const bf16_t* rp = KR + (size_t)key * 64;
#pragma unroll 4
            for (int d8 = 0; d8 < 8; ++d8) { const u32x4 w = *(const u32x4*)(rp + d8 * 8); LAS const float* qq = qs + 128 + d8 * 8;
                s += qq[0] * bf_lo(w.x) + qq[1] * bf_hi(w.x) + qq[2] * bf_lo(w.y) + qq[3] * bf_hi(w.y) + qq[4] * bf_lo(w.z) + qq[5] * bf_hi(w.z) + qq[6] * bf_lo(w.w) + qq[7] * bf_hi(w.w); }
            if (key > q) s = -INFINITY;
            const float mnew = fmaxf(mrun, wave_max(s));
            const float al = exp2f(mrun - mnew), pr = exp2f(s - mnew);
            mrun = mnew; l = l * al + pr;
            const bf16_t* vp = VT + (size_t)(h * 128) * S_ + tokperm(key);
#pragma unroll
            for (int d = 0; d < 128; ++d) o[d] = o[d] * al + pr * __uint_as_float((unsigned)vp[(size_t)d * S_] << 16);
        }
        const float linv = 1.0f / wave_sum(l);
        float r0 = 0.f, r1 = 0.f;
#pragma unroll
        for (int d = 0; d < 128; ++d) { const float t = wave_sum(o[d]); if (lane == (d & 63)) { if (d < 64) r0 = t; else r1 = t; } }
        const size_t o0 = (size_t)q * 2048 + h * 128 + lane;
        const size_t g0 = (size_t)q * 4096 + 2048 + h * 128 + lane;
        const float m0 = __uint_as_float((unsigned)MIX[o0] << 16) + __uint_as_float((unsigned)G[g0] << 16) * r0 * linv;
        const float m1 = __uint_as_float((unsigned)MIX[o0 + 64] << 16) + __uint_as_float((unsigned)G[g0 + 64] << 16) * r1 * linv;
        MIX[o0] = (bf16_t)(cvt_pk_bf16(m0, 0.f) & 0xffffu); MIX[o0 + 64] = (bf16_t)(cvt_pk_bf16(m1, 0.f) & 0xffffu);
    }
}

typedef float f32x16 __attribute__((ext_vector_type(16)));
__device__ __forceinline__ unsigned cvtpk_s(float lo, float hi) { f32x2_t v = {lo, hi}; bf16x2_t b = __builtin_convertvector(v, bf16x2_t); return __builtin_bit_cast(unsigned, b); }
constexpr int KNP = 272, KRP = 144, VP = 144;
constexpr int KNI = 64 * KNP, KRI = 64 * KRP, KBUF = KNI + KRI, VBUF = 128 * VP;
constexpr int LDS_VB = 2 * KBUF, LDS_QR = LDS_VB + 2 * VBUF;

#define ATT_KLD(kb_, hh_) do { _Pragma("unroll") for (int ks = 0; ks < 8; ++ks) kf[ks] = *(LAS const bf16x8*)((kb_) + kaddr_n + (hh_) * 32 * KNP + ks * 32); \
        _Pragma("unroll") for (int ks = 8; ks < 12; ++ks) kf[ks] = *(LAS const bf16x8*)((kb_) + kaddr_r + (hh_) * 32 * KRP + (ks - 8) * 32); } while (0)
#define ATT_QLD() do { _Pragma("unroll") for (int j = 0; j < 4; ++j) qr[j] = *(LAS const bf16x8*)(qrb + j * 32); } while (0)
#define ATT_QK() do { _Pragma("unroll") for (int r = 0; r < 16; ++r) s0[r] = 0.f; \
        _Pragma("unroll") for (int ks = 0; ks < 12; ++ks) { const bf16x8 bq = ks < 8 ? qf[ks < 8 ? ks : 0] : qr[ks < 8 ? 0 : ks - 8]; s0 = __builtin_amdgcn_mfma_f32_32x32x16_bf16(kf[ks], bq, s0, 0, 0, 0); } } while (0)
#define ATT_VLD(vb_, hh_) do { _Pragma("unroll") for (int ks = 0; ks < 2; ++ks) _Pragma("unroll") for (int b = 0; b < 4; ++b) vf[ks][b] = *(LAS const bf16x8*)((vb_) + b * 32 * VP + (hh_) * 64 + ks * 32); } while (0)
#define ATT_SOFTMAX(kbase_) do { \
        if ((kbase_) + 31 > R) { _Pragma("unroll") for (int r = 0; r < 16; ++r) { const int key = (kbase_) + (r & 3) + 8 * (r >> 2) + 4 * hl; if (key > qrow) s0[r] = -INFINITY; } } \
        float mx = s0[0]; \
        _Pragma("unroll") for (int r = 1; r < 16; ++r) mx = fmaxf(mx, s0[r]); \
        { const auto rr_ = __builtin_amdgcn_permlane32_swap(__float_as_uint(mx), __float_as_uint(mx), false, false); mx = fmaxf(__uint_as_float(rr_[0]), __uint_as_float(rr_[1])); }     \
        if (__any(mx > mrun + 8.0f)) { const float mnew = fmaxf(mrun, mx); const float alpha = __builtin_amdgcn_exp2f(mrun - mnew); mrun = mnew; lrun *= alpha; \
            _Pragma("unroll") for (int b = 0; b < 4; ++b) _Pragma("unroll") for (int r = 0; r < 16; ++r) o[b][r] *= alpha; } \
        float ps = 0.f; \
        _Pragma("unroll") for (int r = 0; r < 16; ++r) { s0[r] = __builtin_amdgcn_exp2f(s0[r] - mrun); ps += s0[r]; } \
        lrun += ps; \
        _Pragma("unroll") for (int s = 0; s < 2; ++s) { \
            pk[s].x = cvtpk_s(s0[8 * s + 0], s0[8 * s + 1]); pk[s].y = cvtpk_s(s0[8 * s + 2], s0[8 * s + 3]); pk[s].z = cvtpk_s(s0[8 * s + 4], s0[8 * s + 5]); pk[s].w = cvtpk_s(s0[8 * s + 6], s0[8 * s + 7]); } } while (0)
#define ATT_PVM() do { __builtin_amdgcn_s_setprio(1); _Pragma("unroll") for (int ks = 0; ks < 2; ++ks) { const bf16x8 pb = __builtin_bit_cast(bf16x8, pk[ks]); \
        _Pragma("unroll") for (int b = 0; b < 4; ++b) o[b] = __builtin_amdgcn_mfma_f32_32x32x16_bf16(vf[ks][b], pb, o[b], 0, 0, 0); } __builtin_amdgcn_s_setprio(0); } while (0)

template <int MODE> __device__ __forceinline__ void attn_unit(const Params& p, LAS unsigned char* lds, int h, int qb, bf16_t* MIX) {
    int tid_ = threadIdx.x; asm volatile("" : "+v"(tid_));
    const int tid = tid_, wid = __builtin_amdgcn_readfirstlane(tid >> 6), lane = tid & 63, c = lane & 31, hl = lane >> 5;
    const bf16_t* Q = (const bf16_t*)(p.ws + WS_Q); const bf16_t* KN = (const bf16_t*)p.out; const bf16_t* VT = (const bf16_t*)p.out + (size_t)S_ * 2048;
    const bf16_t* KR = (const bf16_t*)(p.ws + WS_KR); const bf16_t* G = (const bf16_t*)(p.ws + WS_G);
    const int q0 = qb * 256, R = q0 + wid * 32, qrow = R + c;
    const int nkt = 4 * (qb + 1);
    unsigned goff[6];
#pragma unroll
    for (int i = 0; i < 6; ++i) { const int j = wid + 8 * i;
        if (j < 17) { const int bo = j * 1024 + lane * 16, row = bo / KNP; int cb = bo - row * KNP; if (cb >= 256) cb = 0; goff[i] = (unsigned)((row * 2048 + h * 128) * 2 + cb); }
        else if (j < 26) { const int bo = (j - 17) * 1024 + lane * 16, row = bo / KRP; int cb = bo - row * KRP; if (cb >= 128) cb = 0; goff[i] = (unsigned)(row * 64 * 2 + cb); }
        else { const int bo = (j - 26) * 1024 + lane * 16, row = bo / VP; int cb = bo - row * VP; if (cb >= 128) cb = 0; goff[i] = (unsigned)((h * 128 + row) * S_ * 2 + cb); } }
#define ATT_DMA(kt_) do { const int b_ = (kt_) & 1; _Pragma("unroll") for (int i = 0; i < 6; ++i) { const int j = wid + 8 * i; if (j < 44) { \
            const char* gb; unsigned st; int dst; \
            if (j < 17) { gb = (const char*)KN; st = 64u * 2048u * 2u; dst = b_ * KBUF + j * 1024; } \
            else if (j < 26) { gb = (const char*)KR; st = 64u * 64u * 2u; dst = b_ * KBUF + KNI + (j - 17) * 1024; } \
            else { gb = (const char*)VT; st = 128u; dst = LDS_VB + b_ * VBUF + (j - 26) * 1024; } \
            __builtin_amdgcn_global_load_lds((const unsigned*)(gb + (goff[i] + (unsigned)(kt_) * st)), (LAS unsigned*)(lds + dst), 16, 0, 0); } } } while (0)
#define ATT_DMA_WAIT() asm volatile("s_waitcnt vmcnt(0)" ::: "memory")
    bf16x8 qf[8];
    LAS unsigned char* qrb = lds + LDS_QR + wid * (32 * VP) + c * VP + hl * 16;
    { const bf16_t* qp = Q + (size_t)qrow * 3072 + h * 192 + hl * 8;
#pragma unroll
      for (int ks = 0; ks < 8; ++ks) qf[ks] = *(const bf16x8*)(qp + ks * 16);
#pragma unroll
      for (int ks = 8; ks < 12; ++ks) *(LAS bf16x8*)(qrb + (ks - 8) * 32) = *(const bf16x8*)(qp + ks * 16); }
    f32x16 o[4];
#pragma unroll
    for (int b = 0; b < 4; ++b)
#pragma unroll
        for (int r = 0; r < 16; ++r) o[b][r] = 0.f;
    float mrun = -INFINITY, lrun = 0.f;
    u32x4 pk[2];
    ATT_DMA(0); ATT_DMA_WAIT();
    __syncthreads();
    const int kaddr_n = c * KNP + hl * 16, kaddr_r = KNI + c * KRP + hl * 16, vaddr = LDS_VB + c * VP + hl * 16;
    f32x16 s0;
#pragma unroll
    for (int ks = 0; ks < 8; ++ks) asm volatile("" :: "v"(qf[ks]));
    const int tmax = (R + 31) >> 6;
    bf16x8 kf[12], qr[4], vf[2][4];
    ATT_QLD(); ATT_KLD(lds, 0);
#pragma unroll 1
    for (int kt = 0; kt < nkt; ++kt) {
        if (!(MODE & 1)) { if (kt + 1 < nkt) ATT_DMA(kt + 1); }
        __builtin_amdgcn_sched_barrier(0);
        const int key0 = kt * 64;
        LAS const unsigned char* kb = lds + (kt & 1) * KBUF;
        LAS const unsigned char* vb = lds + (kt & 1) * VBUF + vaddr;
        const bool need = !(MODE & 2) && kt <= tmax;
        if (need) {
            __builtin_amdgcn_s_setprio(1);
            ATT_QK(); ATT_VLD(vb, 0); ATT_KLD(kb, 1);
#pragma unroll
            for (int i_ = 0; i_ < 12; ++i_) { __builtin_amdgcn_sched_group_barrier(0x008, 1, 0); __builtin_amdgcn_sched_group_barrier(0x100, 2, 0); }
            __builtin_amdgcn_s_setprio(0); __builtin_amdgcn_sched_barrier(0);
            ATT_SOFTMAX(key0); __builtin_amdgcn_sched_barrier(0);
            ATT_PVM(); __builtin_amdgcn_sched_barrier(0);
            __builtin_amdgcn_s_setprio(1);
            ATT_QK(); ATT_VLD(vb, 1);
#pragma unroll
            for (int i_ = 0; i_ < 12; ++i_) { __builtin_amdgcn_sched_group_barrier(0x008, 1, 0); __builtin_amdgcn_sched_group_barrier(0x100, 1, 0); }
            __builtin_amdgcn_s_setprio(0); __builtin_amdgcn_sched_barrier(0);
            ATT_SOFTMAX(key0 + 32); __builtin_amdgcn_sched_barrier(0);
        }
        asm volatile("s_waitcnt vmcnt(0) lgkmcnt(0)" ::: "memory");
        __syncthreads();
        if (kt + 1 <= tmax && kt + 1 < nkt) { ATT_KLD(lds + ((kt + 1) & 1) * KBUF, 0); }
        __builtin_amdgcn_sched_barrier(0);
        if (need) ATT_PVM();
    }
    __syncthreads();
#undef ATT_DMA
#undef ATT_DMA_WAIT
    { const auto rr_ = __builtin_amdgcn_permlane32_swap(__float_as_uint(lrun), __float_as_uint(lrun), false, false); lrun = __uint_as_float(rr_[0]) + __uint_as_float(rr_[1]); }
    const float inv = 1.0f / lrun;
    {
        LAS unsigned char* ow = lds + wid * (32 * 528);
#pragma unroll
        for (int b = 0; b < 4; ++b)
#pragma unroll
            for (int j = 0; j < 4; ++j) {
                const f32x4 v = {o[b][4 * j + 0] * inv, o[b][4 * j + 1] * inv, o[b][4 * j + 2] * inv, o[b][4 * j + 3] * inv};
                *(LAS f32x4*)(ow + c * 528 + (32 * b + 8 * j + 4 * hl) * 4) = v;
            }
#pragma unroll
        for (int i = 0; i < 8; ++i) {
            const int id = i * 64 + lane, row = id >> 4, cc = id & 15;
            const f32x4 a = *(LAS const f32x4*)(ow + row * 528 + cc * 32), b = *(LAS const f32x4*)(ow + row * 528 + cc * 32 + 16);
            const size_t mo = (size_t)(R + row) * 2048 + h * 128 + cc * 8, go = (size_t)(R + row) * 4096 + 2048 + h * 128 + cc * 8;
            const u32x4 mw = *(const u32x4*)(MIX + mo), gw = __builtin_nontemporal_load((const u32x4*)(G + go));
            f32x4 r0, r1;
            r0[0] = bf_lo(mw.x) + bf_lo(gw.x) * a[0]; r0[1] = bf_hi(mw.x) + bf_hi(gw.x) * a[1]; r0[2] = bf_lo(mw.y) + bf_lo(gw.y) * a[2]; r0[3] = bf_hi(mw.y) + bf_hi(gw.y) * a[3];
            r1[0] = bf_lo(mw.z) + bf_lo(gw.z) * b[0]; r1[1] = bf_hi(mw.z) + bf_hi(gw.z) * b[1]; r1[2] = bf_lo(mw.w) + bf_lo(gw.w) * b[2]; r1[3] = bf_hi(mw.w) + bf_hi(gw.w) * b[3];
            *(u32x4*)(MIX + mo) = pack8(r0, r1);
        }
    }
    __syncthreads();
}

template <int MODE> __device__ __forceinline__ void attn_phase(const Params& p, LAS unsigned char* lds, bf16_t* MIX) {
    for (int P = blockIdx.x; P < 512; P += gridDim.x) {
        const int r = P >> 8, bp = P & 255, xcd = bp & 7, slot = bp >> 3, h = xcd + 8 * r;
#pragma unroll 1
        for (int j = 0; j < 2; ++j) attn_unit<MODE>(p, lds, h, j == 0 ? 63 - slot : slot, MIX);
    }
}

#define XB_TMO      128
#define XB_XCNT(j)  (256  + 64 * (j))
#define XB_XSUB(j)  (1280 + 64 * (j))
#define XB_XGEN(j)  (2304 + 64 * (j))
#define XB_TOP      3328
#define XB_TOPGEN   3392
#define XCD_BAR_WORDS 3456
#define XB_SPIN_CAP (1u << 18)
__device__ __forceinline__ unsigned xb_ld(unsigned* p)              { return __hip_atomic_load(p, __ATOMIC_RELAXED, __HIP_MEMORY_SCOPE_AGENT); }
__device__ __forceinline__ unsigned xb_add(unsigned* p, unsigned v) { return __hip_atomic_fetch_add(p, v, __ATOMIC_RELAXED, __HIP_MEMORY_SCOPE_AGENT); }
__device__ __forceinline__ unsigned xb_xcc_id() { return (unsigned)__builtin_amdgcn_s_getreg((3 << 11) | 20) & 0xFu; }
#define XB_SPIN(cond, bar) do { unsigned _sp = 0; while (cond) { __builtin_amdgcn_s_sleep(1); \
    if ((++_sp & 255u) == 0u) { if (xb_ld(&(bar)[XB_TMO])) break; if (_sp > XB_SPIN_CAP) { atomicAdd(&(bar)[XB_TMO], 1u); break; } } } } while (0)
struct XcdBarrier { unsigned* bar; unsigned x; volatile LAS unsigned* st; };
__device__ __forceinline__ XcdBarrier xcd_barrier_post(unsigned* bar, volatile LAS unsigned* st) {
    XcdBarrier b; b.bar = bar; b.x = xb_xcc_id(); b.st = st;
    if (threadIdx.x == 0) (void)xb_add(&bar[XB_XCNT(b.x)], 1u);
    return b;
}
__device__ __forceinline__ void xcd_barrier_complete(unsigned* bar, unsigned x, unsigned& nloc, unsigned& nx) {
    const unsigned G = gridDim.x * gridDim.y * gridDim.z;
    unsigned sum, cnt, mine, sp = 0u;
    for (;;) {
        sum = 0u; cnt = 0u; mine = 0u;
#pragma unroll
        for (unsigned j = 0; j < 16; ++j) { const unsigned c = xb_ld(&bar[XB_XCNT(j)]); sum += c; cnt += (c > 0u) ? 1u : 0u; mine = (j == x) ? c : mine; }
        if (sum == G) break;
        __builtin_amdgcn_s_sleep(1);
        if ((++sp & 255u) == 0u) { if (xb_ld(&bar[XB_TMO])) break; if (sp > XB_SPIN_CAP) { atomicAdd(&bar[XB_TMO], 1u); break; } }
    }
    nloc = mine > 0u ? mine : 1u; nx = cnt > 0u ? cnt : 1u;
}
__device__ __forceinline__ void xcd_barrier(const XcdBarrier& b) {
    asm volatile("s_waitcnt vmcnt(0)" ::: "memory");
    __syncthreads();
    if (threadIdx.x == 0) {
        unsigned* bar = b.bar;
        __builtin_amdgcn_s_waitcnt(0);
        unsigned nloc = b.st[0], nx = b.st[1];
        if (nloc == 0u) { xcd_barrier_complete(bar, b.x, nloc, nx); b.st[0] = nloc; b.st[1] = nx; }
        const unsigned old = xb_add(&bar[XB_XSUB(b.x)], 1u);
        const unsigned gen = old / nloc;
        if (old + 1u == (gen + 1u) * nloc) {
            __builtin_amdgcn_fence(__ATOMIC_RELEASE, "agent");
            asm volatile("s_waitcnt vmcnt(0)" ::: "memory");
            const unsigned og = xb_add(&bar[XB_TOP], 1u);
            const unsigned tg = og / nx;
            if (og + 1u == (tg + 1u) * nx) xb_add(&bar[XB_TOPGEN], 1u);
            else XB_SPIN(xb_ld(&bar[XB_TOPGEN]) == tg, bar);
            __builtin_amdgcn_fence(__ATOMIC_ACQUIRE, "agent");
            xb_add(&bar[XB_XGEN(b.x)], 1u);
            asm volatile("s_waitcnt vmcnt(0)" ::: "memory");
        } else {
            XB_SPIN(xb_ld(&bar[XB_XGEN(b.x)]) == gen, bar);
            __builtin_amdgcn_fence(__ATOMIC_ACQUIRE, "agent");
            asm volatile("s_waitcnt vmcnt(0)" ::: "memory");
        }
    }
    __syncthreads();
}

__global__ void __launch_bounds__(512, 2) mega_fwd(Params p) {
    extern __shared__ __attribute__((aligned(16))) unsigned char lds_raw[];
    LAS unsigned char* lds = (LAS unsigned char*)lds_raw;
    cg::grid_group grid = cg::this_grid();
    volatile LAS unsigned* xb_st = (volatile LAS unsigned*)(lds + LDS_BYTES - 16);
    if (threadIdx.x == 0) { xb_st[0] = 0u; xb_st[1] = 0u; }
    __syncthreads();
    const XcdBarrier xbar = xcd_barrier_post((unsigned*)(p.ws + WS_BAR), xb_st);
    unsigned char* ws = p.ws;
    const int G = gridDim.x, bid = blockIdx.x;
    float* cosT = (float*)(ws + WS_COS); float* sinT = (float*)(ws + WS_SIN);
    float* ssq = (float*)(ws + WS_SSQ); float* sskv = (float*)(ws + WS_SSKV);
    bf16_t* KN = (bf16_t*)p.out; bf16_t* VT = (bf16_t*)p.out + (size_t)S_ * 2048;

#ifndef PM
#define PM 0xffff
#endif
#if PROBE == 100
    p0_prologue(p, lds); grid.sync();
#endif
    if (PM & 1) p0_prologue(p, lds);
    if (p.use_cg) grid.sync(); else xcd_barrier(xbar);
    if (PM & 2) {
        Gemm g{(const bf16_t*)(ws + WS_XB), (const bf16_t*)(ws + W_IN), 2048, 2048, 2048}; StaticOrder S; S.init(S_, NIN, G, bid);
        EpiZ E{(bf16_t*)(ws + WS_UBUF), (bf16_t*)(ws + WS_CQ), (bf16_t*)(ws + WS_CKV), (bf16_t*)(ws + WS_G), (bf16_t*)(ws + WS_KR), ssq, sskv, cosT, sinT};
        gemm_phase<EpiZ, StaticOrder>(lds, g, S, E);
        deferred_transposes(p, lds);
    }
    xcd_barrier(xbar);
    if (PM & 4) {
        { Gemm g{(const bf16_t*)(ws + WS_UBUF), (const bf16_t*)(ws + W_SA), 384, 256, 256}; ScanOrder S{G, bid}; EpiSA E{(float*)(ws + WS_SCH)}; gemm_phase<EpiSA, ScanOrder>(lds, g, S, E); }
        { Gemm g{(const bf16_t*)(ws + WS_CQ), (const bf16_t*)(ws + W_UQ), 512, 512, 512}; StaticOrder S; S.init(S_, 3072, G, bid); EpiQ E{(bf16_t*)(ws + WS_Q), ssq, cosT, sinT}; gemm_phase<EpiQ, StaticOrder>(lds, g, S, E); }
        { Gemm g{(const bf16_t*)(ws + WS_CKV), (const bf16_t*)(ws + W_UK), 512, 512, 512}; StaticOrder S; S.init(S_, 2048, G, bid); EpiK E{KN, sskv}; gemm_phase<EpiK, StaticOrder>(lds, g, S, E); }
        { Gemm g{(const bf16_t*)(ws + W_UV), (const bf16_t*)(ws + WS_CKV), 512, 512, 512}; StaticOrder S; S.init(2048, S_, G, bid); EpiVT E{VT, sskv}; gemm_phase<EpiVT, StaticOrder>(lds, g, S, E); }
    }
    xcd_barrier(xbar);
#if PROBE == 3
    carry_phase(p, lds); xcd_barrier(xbar);
#endif
    if (PM & 8) carry_phase(p, lds);
    xcd_barrier(xbar);
    if (PM & 16) {
        Gemm g{(const bf16_t*)(ws + WS_UBUF), (const bf16_t*)(ws + W_SC), 384, 384, 384}; ScanOrder S{G, bid}; EpiSC E{(bf16_t*)(ws + WS_YG)}; gemm_phase<EpiSC, ScanOrder>(lds, g, S, E);
    }
    xcd_barrier(xbar);
    if (PM & 32) {
        Gemm g{(const bf16_t*)(ws + WS_YG), (const bf16_t*)(ws + W_GLU), 1024, 1024, 1024}; StaticOrder S; S.init(S_, 4096, G, bid); EpiGLU E{(bf16_t*)(ws + WS_MIX), (const bf16_t*)(ws + WS_G)};
        gemm_phase<EpiGLU, StaticOrder>(lds, g, S, E);
    }
    xcd_barrier(xbar);
#if USE_MFMA_ATTN
#if PROBE == 6
    attn_phase<PROBE_MODE>(p, lds, (bf16_t*)(ws + WS_XB)); xcd_barrier(xbar);
#endif
    if (PM & 64) attn_phase<0>(p, lds, (bf16_t*)(ws + WS_MIX));
#else
    if (PM & 64) attn_naive(p, lds);
#endif
    xcd_barrier(xbar);
    if (PM & 128) {
        Gemm g{(const bf16_t*)(ws + WS_MIX), (const bf16_t*)(ws + W_OUT), 2048, 2048, 2048}; StaticOrder S; S.init(S_, 2048, G, bid); EpiRes E{p.in[0], p.out};
        gemm_phase<EpiRes, StaticOrder, false, true>(lds, g, S, E);
    }
    xcd_barrier(xbar);
    if (PM & 256) ln_phase(p.out, p.in[17], p.in[18], (bf16_t*)(ws + WS_H1B));
    xcd_barrier(xbar);
#if PROBE == 9
    { Gemm g{(const bf16_t*)(ws + WS_H1B), (const bf16_t*)(ws + W_GU), 2048, 2048, 2048}; StaticOrder S; S.init(S_, 2 * DFF, G, bid); EpiFFN E{(bf16_t*)(ws + WS_ACT)};
      gemm_phase<EpiFFN, StaticOrder>(lds, g, S, E); xcd_barrier(xbar); }
#endif
    if (PM & 512) {
        Gemm g{(const bf16_t*)(ws + WS_H1B), (const bf16_t*)(ws + W_GU), 2048, 2048, 2048}; StaticOrder S; S.init(S_, 2 * DFF, G, bid); EpiFFN E{(bf16_t*)(ws + WS_ACT)};
        gemm_phase<EpiFFN, StaticOrder>(lds, g, S, E);
    }
    xcd_barrier(xbar);
    if (PM & 1024) {
        Gemm g{(const bf16_t*)(ws + WS_ACT), (const bf16_t*)(ws + W_DOWN), DFF, DFF, DFF}; StaticOrder S; S.init(S_, 2048, G, bid); EpiResB E{(const bf16_t*)(ws + WS_H1B), p.out};
        gemm_phase<EpiResB, StaticOrder, false, true>(lds, g, S, E);
    }
    xcd_barrier(xbar);
    if (PM & 2048) ln_phase(p.out, p.in[22], p.in[23], nullptr);
}

extern "C" void kernel_launch(void* const* d_in, const int* in_sizes, int n_in, void* d_out, int out_size, void* d_ws, size_t ws_size, hipStream_t stream) {
    static int grid = 0;
    if (grid == 0) {
        if (n_in != 24 || out_size != S_ * D_ || ws_size < WS_END) { fprintf(stderr, "kernel_launch: unexpected shapes n_in %d out %d ws %zu\n", n_in, out_size, ws_size); grid = -1; return; }
        int dev = 0, cus = 0, per_cu = 0;
        hipGetDevice(&dev); hipDeviceGetAttribute(&cus, hipDeviceAttributeMultiprocessorCount, dev);
        if (hipFuncSetAttribute((const void*)mega_fwd, hipFuncAttributeMaxDynamicSharedMemorySize, LDS_BYTES) != hipSuccess) { fprintf(stderr, "kernel_launch: hipFuncSetAttribute failed\n"); grid = -1; return; }
        if (hipOccupancyMaxActiveBlocksPerMultiprocessor(&per_cu, (const void*)mega_fwd, 512, LDS_BYTES) != hipSuccess || per_cu < 1) per_cu = 1;
        (void)hipGetLastError();
        grid = cus * 1;
    }
    if (grid < 0) return;
    Params p{};
    for (int i = 0; i < 24; ++i) p.in[i] = (const float*)d_in[i];
    p.out = (float*)d_out; p.ws = (unsigned char*)d_ws;
    for (int i = 0; i < 32; ++i) p.inv_freq[i] = 1.0 / pow(10000.0, (double)(2 * i) / 64.0);
    (void)hipMemsetAsync((unsigned char*)d_ws + WS_BAR, 0, BAR_BYTES, stream);
    void* args[] = {&p};
    hipError_t e = hipLaunchCooperativeKernel((const void*)mega_fwd, dim3(grid), dim3(512), args, LDS_BYTES, stream);
    if (e != hipSuccess) fprintf(stderr, "cooperative launch failed: %s (grid %d)\n", hipGetErrorString(e), grid);
}
```
